# Optimizing an MI355X kernel written in HIP

```python
import math
import jax, jax.numpy as jnp
from jax import lax
import numpy as np

D_MODEL = 1024
BATCH = 32
SEQ = 256
DEPTH = 4
DEC_BATCH = 4
DEC_SEQ = 4096
PAST_LEN = 512

GRID_W = 64
N_MIXERS = 3
N_SC = len(range(0, DEPTH, N_MIXERS))
N_MLA = len(range(1, DEPTH, N_MIXERS))
N_HY = len(range(2, DEPTH, N_MIXERS))
D_FF = 4 * D_MODEL
MOD_CHUNKS = 6
EPS = 1e-6
N_HEADS = 16
QK_NOPE = 64
ROPE_DIM = 32
AXIS_ROPE = ROPE_DIM // 2
QK_DIM = QK_NOPE + ROPE_DIM
V_DIM = 64
Q_RANK = 384
KV_RANK = 256
ROPE_THETA = 10000.0
Q_BLOCK = 128
HY_EMB = 33
HY_BANDS = (HY_EMB - 1) // 2
HY_ORDER = 64
HY_TARGET = 1e-2
HY_FAST = 0.3
HY_SLOW = 1.5

kernel_name = 'hybrid_conv_mla_hyena_diffusion_step'

F32 = jnp.float32


def rmsnorm(x, g):
    xf = x.astype(F32)
    y = xf * lax.rsqrt(jnp.mean(xf * xf, axis=-1, keepdims=True) + EPS)
    return (y * g.astype(F32)).astype(x.dtype)


def dwconv3(u, w, b):
    up = jnp.pad(u, ((0, 0), (1, 1), (0, 0)))
    return up[:, :-2] * w[0] + up[:, 1:-1] * w[1] + up[:, 2:] * w[2] + b


def short_conv_mixer(h, w_in, conv_w, conv_b, w_out):
    bg, cg, xv = jnp.split(h @ w_in, 3, axis=-1)
    u = dwconv3(cg * xv, conv_w, conv_b)
    return (bg * u) @ w_out


def hyena_filter(n, w0, b0, w1, b1, w2, b2, w3, freq):
    t01 = jnp.linspace(0.0, 1.0, n, dtype=F32)[:, None]
    w = 2.0 * math.pi * jnp.arange(n, dtype=F32)[:, None] / n
    fb = jnp.linspace(1e-4, HY_BANDS - 1, HY_BANDS, dtype=F32)[None, :]
    z = jnp.concatenate([t01, jnp.cos(fb * w), -jnp.sin(fb * w)], axis=-1)
    fr = freq.astype(F32)
    a = jnp.sin(fr * (z @ w0.astype(F32) + b0.astype(F32)))
    a = jnp.sin(fr * (a @ w1.astype(F32) + b1.astype(F32)))
    a = jnp.sin(fr * (a @ w2.astype(F32) + b2.astype(F32)))
    hf, hb = jnp.split(a @ w3.astype(F32), 2, axis=-1)
    deltas = jnp.abs(jnp.linspace(math.log(HY_TARGET) / HY_SLOW, math.log(HY_TARGET) / HY_FAST,
                                  D_MODEL, dtype=F32))
    decay = jnp.exp(-t01 * deltas)
    hf = hf * decay
    hb = hb * decay
    filt = jnp.concatenate([hf, jnp.zeros((1, D_MODEL), F32), hb[1:][::-1]], axis=0)
    return filt / jnp.sum(jnp.abs(filt), axis=0, keepdims=True)


def long_conv(v, filt):
    n = v.shape[1]
    vf = jnp.fft.rfft(v.astype(F32), n=2 * n, axis=1)
    ff = jnp.fft.rfft(filt, axis=0)
    y = jnp.fft.irfft(vf * ff[None], n=2 * n, axis=1)[:, :n]
    return y.astype(v.dtype)


def hyena_mixer(h, w_in, conv_w, conv_b, w0, b0, w1, b1, w2, b2, w3, freq, bias, w_out):
    n = h.shape[1]
    x0, x1, v = jnp.split(dwconv3(h @ w_in, conv_w, conv_b), 3, axis=-1)
    filt = hyena_filter(n, w0, b0, w1, b1, w2, b2, w3, freq)
    v = v * x1
    v = long_conv(v, filt) + v * bias
    return (v * x0) @ w_out


def grid_positions(n):
    rows = n // GRID_W
    row = jnp.repeat(jnp.arange(rows), GRID_W)
    col = jnp.tile(jnp.arange(GRID_W), rows)
    return row, col


def axial_rope(x, row, col):
    inv = jnp.power(ROPE_THETA, -jnp.arange(0, AXIS_ROPE, 2, dtype=F32) / AXIS_ROPE)

    def rot(xa, pos):
        ang = pos.astype(F32)[:, None] * inv[None]
        cos = jnp.cos(ang)[None, :, None, :].astype(xa.dtype)
        sin = jnp.sin(ang)[None, :, None, :].astype(xa.dtype)
        x1, x2 = jnp.split(xa, 2, axis=-1)
        return jnp.concatenate([x1 * cos - x2 * sin, x2 * cos + x1 * sin], axis=-1)

    xr, xc = jnp.split(x, 2, axis=-1)
    return jnp.concatenate([rot(xr, row), rot(xc, col)], axis=-1)


def rope_tail(x, row, col):
    return jnp.concatenate([x[..., :QK_NOPE], axial_rope(x[..., QK_NOPE:], row, col)], axis=-1)


def mla_queries(h, w_dq, q_norm_g, w_uq, qn_g):
    b, n, _ = h.shape
    q = (rmsnorm(h @ w_dq, q_norm_g) @ w_uq).reshape(b, n, N_HEADS, QK_DIM)
    return rmsnorm(q, qn_g)


def mla_latent_kv(h, w_dkv, kv_norm_g):
    ckv, kpe = jnp.split(h @ w_dkv, [KV_RANK], axis=-1)
    return rmsnorm(ckv, kv_norm_g), kpe


def mla_expand(ckv, kpe, w_ukv, kn_g):
    b, n, _ = ckv.shape
    kn, v = jnp.split((ckv @ w_ukv).reshape(b, n, N_HEADS, QK_NOPE + V_DIM), [QK_NOPE], axis=-1)
    k = jnp.concatenate([kn, jnp.broadcast_to(kpe[:, :, None, :], (b, n, N_HEADS, ROPE_DIM))], axis=-1)
    return rmsnorm(k, kn_g), v


def block_attention(q, k, v):
    b, n, h, dk = q.shape
    nb = n // Q_BLOCK
    qb = jnp.moveaxis(q.reshape(b, nb, Q_BLOCK, h, dk), 1, 0)
    scale = dk ** -0.5

    def one(qblk):
        s = jnp.einsum('bqhd,bkhd->bhqk', qblk, k, preferred_element_type=F32) * scale
        p = jax.nn.softmax(s, axis=-1).astype(v.dtype)
        return jnp.einsum('bhqk,bkhd->bqhd', p, v)

    o = lax.map(one, qb)
    return jnp.moveaxis(o, 0, 1).reshape(b, n, h * v.shape[-1])


def mla_context(h, P, j):
    q = mla_queries(h, P['mla_w_dq'][j], P['mla_q_norm_g'][j], P['mla_w_uq'][j], P['mla_qn_g'][j])
    ckv, kpe = mla_latent_kv(h, P['mla_w_dkv'][j], P['mla_kv_norm_g'][j])
    k, v = mla_expand(ckv, kpe, P['mla_w_ukv'][j], P['mla_kn_g'][j])
    return block_attention(q, k, v) @ P['mla_w_o'][j], ckv, kpe


def mla_latent(h, ctx_ckv, ctx_kpe, P, j):
    row, col = grid_positions(h.shape[1])
    q = rope_tail(mla_queries(h, P['mla_w_dq'][j], P['mla_q_norm_g'][j], P['mla_w_uq'][j],
                              P['mla_qn_g'][j]), row, col)
    ckv, kpe = mla_latent_kv(h, P['mla_w_dkv'][j], P['mla_kv_norm_g'][j])
    k, v = mla_expand(ckv, kpe, P['mla_w_ukv'][j], P['mla_kn_g'][j])
    k = rope_tail(k, row, col)
    kc, vc = mla_expand(ctx_ckv, ctx_kpe, P['mla_w_ukv'][j], P['mla_kn_g'][j])
    o = block_attention(q, jnp.concatenate([k, kc], axis=1), jnp.concatenate([v, vc], axis=1))
    return o @ P['mla_w_o'][j]


def trunk(x, cond, P, cache_ckv=None, cache_kpe=None):
    is_context = cache_ckv is None
    ckvs, kpes = [], []
    for i in range(DEPTH):
        kind, j = i % N_MIXERS, i // N_MIXERS
        sh1, sc1, g1, sh2, sc2, g2 = jnp.split(jax.nn.silu(cond) @ P['mod_w'][i] + P['mod_b'][i],
                                               MOD_CHUNKS, axis=-1)
        h = rmsnorm(x, P['norm1_g'][i]) * (1 + sc1) + sh1
        if kind == 0:
            y = short_conv_mixer(h, P['sc_w_in'][j], P['sc_conv_w'][j], P['sc_conv_b'][j], P['sc_w_out'][j])
        elif kind == 1:
            if is_context:
                y, ckv, kpe = mla_context(h, P, j)
                ckvs.append(ckv)
                kpes.append(kpe)
            else:
                y = mla_latent(h, cache_ckv[:, j], cache_kpe[:, j], P, j)
        else:
            y = hyena_mixer(h, P['hy_w_in'][j], P['hy_conv_w'][j], P['hy_conv_b'][j],
                            P['hy_f_w0'][j], P['hy_f_b0'][j], P['hy_f_w1'][j], P['hy_f_b1'][j],
                            P['hy_f_w2'][j], P['hy_f_b2'][j], P['hy_f_w3'][j], P['hy_sin_freq'][j],
                            P['hy_bias'][j], P['hy_w_out'][j])
        x = x + g1 * y
        h = rmsnorm(x, P['norm2_g'][i]) * (1 + sc2) + sh2
        x = x + g2 * (jnp.square(jax.nn.relu(h @ P['mlp_w1'][i])) @ P['mlp_w2'][i])
    return x, ckvs, kpes


def setup_inputs(seed: int = 0) -> dict:
    key = jax.random.key(seed)
    ks = iter(jax.random.split(key, 64))

    def nrm(shape, scale):
        return scale * jax.random.normal(next(ks), shape, F32)

    def gain(shape):
        return 1.0 + nrm(shape, 0.02)

    D = D_MODEL
    return {
        'x_prompt': nrm((BATCH, SEQ, D), 1.0),
        'x_sample': nrm((DEC_BATCH, DEC_SEQ, D), 1.0),
        'cache_ckv': nrm((DEC_BATCH, N_MLA, PAST_LEN, KV_RANK), 1.0),
        'cache_kpe': nrm((DEC_BATCH, N_MLA, PAST_LEN, ROPE_DIM), 1.0),
        'c': nrm((DEC_BATCH, D), 1.0),
        'c_ctx': nrm((D,), 1.0),
        'norm1_g': gain((DEPTH, D)),
        'norm2_g': gain((DEPTH, D)),
        'mod_w': nrm((DEPTH, D, MOD_CHUNKS * D), 0.5 * D ** -0.5),
        'mod_b': nrm((DEPTH, MOD_CHUNKS * D), 0.02),
        'mlp_w1': nrm((DEPTH, D, D_FF), D ** -0.5),
        'mlp_w2': nrm((DEPTH, D_FF, D), D_FF ** -0.5),
        'sc_w_in': nrm((N_SC, D, 3 * D), D ** -0.5),
        'sc_conv_w': nrm((N_SC, 3, D), 3 ** -0.5),
        'sc_conv_b': nrm((N_SC, D), 0.02),
        'sc_w_out': nrm((N_SC, D, D), D ** -0.5),
        'mla_w_dq': nrm((N_MLA, D, Q_RANK), D ** -0.5),
        'mla_q_norm_g': gain((N_MLA, Q_RANK)),
        'mla_w_uq': nrm((N_MLA, Q_RANK, N_HEADS * QK_DIM), Q_RANK ** -0.5),
        'mla_w_dkv': nrm((N_MLA, D, KV_RANK + ROPE_DIM), D ** -0.5),
        'mla_kv_norm_g': gain((N_MLA, KV_RANK)),
        'mla_w_ukv': nrm((N_MLA, KV_RANK, N_HEADS * (QK_NOPE + V_DIM)), KV_RANK ** -0.5),
        'mla_qn_g': gain((N_MLA, QK_DIM)),
        'mla_kn_g': gain((N_MLA, QK_DIM)),
        'mla_w_o': nrm((N_MLA, N_HEADS * V_DIM, D), (N_HEADS * V_DIM) ** -0.5),
        'hy_w_in': nrm((N_HY, D, 3 * D), D ** -0.5),
        'hy_conv_w': nrm((N_HY, 3, 3 * D), 3 ** -0.5),
        'hy_conv_b': nrm((N_HY, 3 * D), 0.02),
        'hy_f_w0': nrm((N_HY, HY_EMB, HY_ORDER), HY_EMB ** -0.5),
        'hy_f_b0': nrm((N_HY, HY_ORDER), 0.02),
        'hy_f_w1': nrm((N_HY, HY_ORDER, HY_ORDER), HY_ORDER ** -0.5),
        'hy_f_b1': nrm((N_HY, HY_ORDER), 0.02),
        'hy_f_w2': nrm((N_HY, HY_ORDER, HY_ORDER), HY_ORDER ** -0.5),
        'hy_f_b2': nrm((N_HY, HY_ORDER), 0.02),
        'hy_f_w3': nrm((N_HY, HY_ORDER, 2 * D), HY_ORDER ** -0.5),
        'hy_sin_freq': gain((N_HY, HY_ORDER)),
        'hy_bias': nrm((N_HY, D), 0.1),
        'hy_w_out': nrm((N_HY, D, D), D ** -0.5),
    }


def reference(x_prompt, x_sample, cache_ckv, cache_kpe, c, c_ctx, norm1_g, norm2_g, mod_w, mod_b,
              mlp_w1, mlp_w2, sc_w_in, sc_conv_w, sc_conv_b, sc_w_out, mla_w_dq, mla_q_norm_g,
              mla_w_uq, mla_w_dkv, mla_kv_norm_g, mla_w_ukv, mla_qn_g, mla_kn_g, mla_w_o, hy_w_in,
              hy_conv_w, hy_conv_b, hy_f_w0, hy_f_b0, hy_f_w1, hy_f_b1, hy_f_w2, hy_f_b2, hy_f_w3,
              hy_sin_freq, hy_bias, hy_w_out):
    P = dict(norm1_g=norm1_g, norm2_g=norm2_g, mod_w=mod_w, mod_b=mod_b, mlp_w1=mlp_w1,
             mlp_w2=mlp_w2, sc_w_in=sc_w_in, sc_conv_w=sc_conv_w, sc_conv_b=sc_conv_b,
             sc_w_out=sc_w_out, mla_w_dq=mla_w_dq, mla_q_norm_g=mla_q_norm_g, mla_w_uq=mla_w_uq,
             mla_w_dkv=mla_w_dkv, mla_kv_norm_g=mla_kv_norm_g, mla_w_ukv=mla_w_ukv,
             mla_qn_g=mla_qn_g, mla_kn_g=mla_kn_g, mla_w_o=mla_w_o, hy_w_in=hy_w_in,
             hy_conv_w=hy_conv_w, hy_conv_b=hy_conv_b, hy_f_w0=hy_f_w0, hy_f_b0=hy_f_b0,
             hy_f_w1=hy_f_w1, hy_f_b1=hy_f_b1, hy_f_w2=hy_f_w2, hy_f_b2=hy_f_b2, hy_f_w3=hy_f_w3,
             hy_sin_freq=hy_sin_freq, hy_bias=hy_bias, hy_w_out=hy_w_out)
    y_prompt, ckvs, kpes = trunk(x_prompt, c_ctx[None, None, :], P)
    new_ckv = jnp.stack(ckvs, axis=1)
    new_kpe = jnp.stack(kpes, axis=1)
    y_sample, _, _ = trunk(x_sample, c[:, None, :], P, cache_ckv, cache_kpe)
    return (y_prompt, y_sample, new_ckv, new_kpe)
```

```cpp
#include <hip/hip_runtime.h>
#include <hip/hip_cooperative_groups.h>
#include <cstdio>
#include <cstdint>
namespace cg = cooperative_groups;

#ifndef ONE_LAUNCH
#define ONE_LAUNCH 1
#endif

#ifndef DUP_MASK
#define DUP_MASK 0u
#endif
#ifndef EXTRA_SYNCS
#define EXTRA_SYNCS 0
#endif
#define LAS __attribute__((address_space(3)))
typedef unsigned short bf16_t;
typedef short bf16x8 __attribute__((ext_vector_type(8)));
typedef float f32x4 __attribute__((ext_vector_type(4)));
typedef float f32x2 __attribute__((ext_vector_type(2)));
typedef unsigned u32x4 __attribute__((ext_vector_type(4)));
typedef unsigned u32x2 __attribute__((ext_vector_type(2)));

constexpr int D = 1024, MP = 8192, MS = 16384, M = 24576, NCACHE = 2048, MKV = M + NCACHE, FF = 4096;
constexpr int NPH = 27;
constexpr float EPS = 1e-6f;
constexpr int LDS_BYTES = 147456;
constexpr size_t MiB = 1u << 20;
constexpr size_t WS_MODV = 0;
constexpr size_t WS_GS = 512 * 1024;
constexpr size_t WS_BIAS = 768 * 1024;
constexpr size_t WS_SSQ = 2 * MiB;
constexpr size_t WS_A3 = 4 * MiB;
constexpr size_t WS_BAR = 7 * MiB;
constexpr size_t WS_W = 8 * MiB;
constexpr size_t OFF_SCIN0 = 0, OFF_SCOUT0 = 6 * MiB, OFF_SCIN1 = 8 * MiB, OFF_SCOUT1 = 14 * MiB, OFF_HYIN = 16 * MiB, OFF_HYOUT = 22 * MiB,
                 OFF_WO = 24 * MiB, OFF_DQKV = 26 * MiB, OFF_WUQ = 28 * MiB, OFF_WUKV = 30 * MiB;
constexpr size_t WS_MLP1 = 40 * MiB, WS_MLP2 = 48 * MiB;
constexpr size_t WS_XS = 56 * MiB;
constexpr size_t WS_Z = 104 * MiB;
constexpr size_t WS_AR = 152 * MiB;
constexpr size_t WS_HFB = 344 * MiB;
constexpr size_t WS_END = 380 * MiB;
constexpr size_t AR_KV = 0, AR_QKVL = 0, AR_CQ = 130 * MiB, AR_CKV = 148 * MiB, AR_KPE = 161 * MiB, AR_AO = 130 * MiB;
constexpr int B_IN0 = 0, B_M0 = 15360, B_DQKV = 35840, B_M1 = 39680, B_HY = 60160, B_M2 = 75520, B_IN3 = 96000, B_M3 = 111360;
constexpr int SPS_STRIDE = 4104, SPP_STRIDE = 264;
constexpr size_t SPEC_P_OFF = (size_t)1024 * SPS_STRIDE * 8;
constexpr size_t OUT_CKV = (size_t)M * D, OUT_KPE = OUT_CKV + (size_t)MP * 256;

struct Args { const float* in[38]; float* out; unsigned char* ws; int ph_lo, ph_hi; };

__device__ __forceinline__ unsigned f2bf(float f) { unsigned u = __float_as_uint(f); return (u + 0x7fffu + ((u >> 16) & 1u)) >> 16; }
__device__ __forceinline__ unsigned pk2(float lo, float hi) { return f2bf(lo) | (f2bf(hi) << 16); }
__device__ __forceinline__ float bflo(unsigned w) { return __uint_as_float(w << 16); }
__device__ __forceinline__ float bfhi(unsigned w) { return __uint_as_float(w & 0xffff0000u); }
__device__ __forceinline__ unsigned cvt_pk_bf16(float lo, float hi) { unsigned r; asm volatile("v_cvt_pk_bf16_f32 %0, %1, %2" : "=v"(r) : "v"(lo), "v"(hi)); return r; }
__device__ __forceinline__ float wave_sum(float v) {
#pragma unroll
    for (int o = 1; o < 64; o <<= 1) v += __shfl_xor(v, o);
    return v;
}
__device__ __forceinline__ void unpack8(const u32x4 w, float (&f)[8]) {
    f[0] = bflo(w.x); f[1] = bfhi(w.x); f[2] = bflo(w.y); f[3] = bfhi(w.y); f[4] = bflo(w.z); f[5] = bfhi(w.z); f[6] = bflo(w.w); f[7] = bfhi(w.w);
}
__device__ __forceinline__ u32x4 pack8(const float (&f)[8]) {
    u32x4 w; w.x = pk2(f[0], f[1]); w.y = pk2(f[2], f[3]); w.z = pk2(f[4], f[5]); w.w = pk2(f[6], f[7]); return w;
}
__device__ __forceinline__ int otid() { int t = threadIdx.x; asm volatile("" : "+v"(t)); return t; }
__device__ __forceinline__ float ozero() { float z = 0.f; asm volatile("" : "+v"(z)); return z; }
__device__ __forceinline__ int ogrid() { int g = gridDim.x; asm volatile("" : "+s"(g)); return g; }
__device__ __forceinline__ int obid() { int b = blockIdx.x; asm volatile("" : "+s"(b)); return b; }
__device__ __forceinline__ f32x2 cmul(f32x2 a, f32x2 b) { f32x2 r; r.x = a.x * b.x - a.y * b.y; r.y = a.x * b.y + a.y * b.x; return r; }

namespace pg8 {
constexpr int BM = 256, BK = 64, HALF = 128, HTB = HALF * BK * 2, STAGE_BYTES = 8 * HTB, NXCD = 8, WGM = 8;
__device__ __forceinline__ int lds_byte(int r, int c) { const int st = (r >> 4) * 2 + (c >> 5), rr = r & 15, cc = c & 31, ob = rr * 64 + cc * 2; return st * 1024 + (ob ^ (((ob >> 9) & 1) << 5)); }
__device__ __forceinline__ void stage_rc(int b, int& R, int& C) { const int st = b / 1024, sb = b % 1024, swz = sb ^ (((sb >> 9) & 1) << 5); R = (st >> 1) * 16 + swz / 64; C = (st & 1) * 32 + (swz % 64) / 2; }
__device__ __forceinline__ int perm32(int rho) { const int n = rho >> 4, i = rho & 15; return 8 * (i >> 2) + 4 * n + (i & 3); }
struct Unit { int pm, pn; };
struct Gemm { const bf16_t* A; const bf16_t* Bt; int M, N, K; };
struct StaticOrder {
    int nM, nN, nwg, G, c;
    __device__ void init(int M_, int N_, int G_, int c_) { nM = M_ / BM; nN = N_ / BM; nwg = nM * nN; G = G_; c = c_; }
    __device__ bool next(int i, Unit& u) const {
        const long L = (long)i * G + c; if (L >= nwg) return false;
        int wgid = (int)L; { const int q = nwg / NXCD, r = nwg % NXCD, xcd = wgid % NXCD, off = wgid / NXCD; wgid = (xcd < r ? xcd * (q + 1) : r * (q + 1) + (xcd - r) * q) + off; }
        const int nig = WGM * nN, gid = wgid / nig, fm = gid * WGM, gsz = (nM - fm) < WGM ? (nM - fm) : WGM;
        u.pm = fm + ((wgid % nig) % gsz); u.pn = (wgid % nig) / gsz; return true;
    }
};

struct EpiA {
    void* O; int ldc; const float* bias; int nb; const float* ssq; int act, f32out, norm, remap;
    __device__ __forceinline__ void operator()(const f32x4 (&acc)[2][2][4][2], const Unit& u, int wr, int wc, int fr, int fq) const {
        const int ci = u.pm < 32 ? 0 : 1 + ((u.pm - 32) >> 4);
        const int colb = u.pn * BM + wc * 32 + 8 * fq;
        f32x4 bv[2][2];
#pragma unroll
        for (int bj = 0; bj < 2; ++bj)
#pragma unroll
            for (int n = 0; n < 2; ++n) bv[bj][n] = bias ? *(const f32x4*)(bias + (size_t)ci * nb + colb + bj * HALF + 4 * n) : (f32x4){0.f, 0.f, 0.f, 0.f};
        float rsv0 = 1.f, rsv1 = 1.f;
        if (norm) {
            const f32x4* sp0 = (const f32x4*)(ssq + (size_t)(u.pm * BM + wr * 64 + fq * 16 + fr) * 16); const f32x4* sp1 = sp0 + (size_t)HALF * 4;
            const f32x4 a0 = sp0[0], a1 = sp0[1], a2 = sp0[2], a3 = sp0[3], b0 = sp1[0], b1 = sp1[1], b2 = sp1[2], b3 = sp1[3];
            const f32x4 s0 = (a0 + a1) + (a2 + a3), s1 = (b0 + b1) + (b2 + b3);
            rsv0 = rsqrtf(((s0.x + s0.y) + (s0.z + s0.w)) * (1.0f / 1024.0f) + EPS); rsv1 = rsqrtf(((s1.x + s1.y) + (s1.z + s1.w)) * (1.0f / 1024.0f) + EPS);
        }
#pragma unroll
        for (int ai = 0; ai < 2; ++ai)
#pragma unroll
            for (int m = 0; m < 4; ++m) {
                const int row = u.pm * BM + ai * HALF + wr * 64 + m * 16 + fr;
                const float rs = __shfl(ai ? rsv1 : rsv0, m * 16 + fr);
#pragma unroll
                for (int bj = 0; bj < 2; ++bj) {
                    f32x4 v0 = acc[ai][bj][m][0] * rs + bv[bj][0], v1 = acc[ai][bj][m][1] * rs + bv[bj][1];
                    if (act) {
#pragma unroll
                        for (int e = 0; e < 4; ++e) { const float a0 = fmaxf(v0[e], 0.f), a1 = fmaxf(v1[e], 0.f); v0[e] = a0 * a0; v1[e] = a1 * a1; }
                    }
                    const int c = colb + bj * HALF; const int dc = remap ? (c >> 7) * 160 + (c & 127) : c;
                    if (f32out) { float* p = (float*)O + (size_t)row * ldc + dc; *(f32x4*)p = v0; *(f32x4*)(p + 4) = v1; }
                    else { bf16_t* p = (bf16_t*)O + (size_t)row * ldc + dc; u32x4 w; w.x = cvt_pk_bf16(v0[0], v0[1]); w.y = cvt_pk_bf16(v0[2], v0[3]); w.z = cvt_pk_bf16(v1[0], v1[1]); w.w = cvt_pk_bf16(v1[2], v1[3]); *(u32x4*)p = w; }
                }
            }
    }
};
struct EpiB {
    float* x; const float* g; const float* gsn; bf16_t* xs; float* ssq; const float* xin_p; const float* xin_s;
    __device__ __forceinline__ void operator()(const f32x4 (&acc)[2][2][4][2], const Unit& u, int wr, int wc, int fr, int fq) const {
        const int ci = u.pm < 32 ? 0 : 1 + ((u.pm - 32) >> 4);
        const int colb = u.pn * BM + wc * 32 + 8 * fq;
        f32x4 gv[2][2], sv[2][2];
#pragma unroll
        for (int bj = 0; bj < 2; ++bj)
#pragma unroll
            for (int n = 0; n < 2; ++n) {
                gv[bj][n] = *(const f32x4*)(g + (size_t)ci * 6144 + colb + bj * HALF + 4 * n);
                sv[bj][n] = gsn ? *(const f32x4*)(gsn + (size_t)ci * 1024 + colb + bj * HALF + 4 * n) : (f32x4){0.f, 0.f, 0.f, 0.f};
            }
        const float* xb0 = (xin_p ? (u.pm < 32 ? xin_p : xin_s - (size_t)MP * 1024) : (const float*)x) + (size_t)(u.pm * BM + wr * 64 + fr) * 1024 + colb;
        auto xsrc = [&](int st) -> const float* { const int i = st >> 1; return xb0 + (size_t)((i >> 2) * HALF + (i & 3) * 16) * 1024 + (st & 1) * HALF; };
        f32x4 nxa, nxb;
        { const float* xr = xsrc(0); nxa = *(const f32x4*)xr; nxb = *(const f32x4*)(xr + 4); }
        float ss = 0.f;
#pragma unroll
        for (int st = 0; st < 16; ++st) {
                const int i = st >> 1, bj = st & 1, ai = i >> 2, m = i & 3;
                const int row = u.pm * BM + ai * HALF + wr * 64 + m * 16 + fr;
                float* xp = x + (size_t)row * 1024 + colb;
                f32x4 xa = nxa, xb = nxb;
                if (st < 15) { const float* xr = xsrc(st + 1); nxa = *(const f32x4*)xr; nxb = *(const f32x4*)(xr + 4); }
                if (bj == 0) ss = 0.f;
                {
                    xa = xa + gv[bj][0] * acc[ai][bj][m][0]; xb = xb + gv[bj][1] * acc[ai][bj][m][1];
                    *(f32x4*)(xp + bj * HALF) = xa; *(f32x4*)(xp + bj * HALF + 4) = xb;
                    ss += (xa.x * xa.x + xa.y * xa.y) + (xa.z * xa.z + xa.w * xa.w) + (xb.x * xb.x + xb.y * xb.y) + (xb.z * xb.z + xb.w * xb.w);
                    if (gsn) { const f32x4 ya = xa * sv[bj][0], yb = xb * sv[bj][1]; u32x4 w; w.x = cvt_pk_bf16(ya[0], ya[1]); w.y = cvt_pk_bf16(ya[2], ya[3]); w.z = cvt_pk_bf16(yb[0], yb[1]); w.w = cvt_pk_bf16(yb[2], yb[3]);
                        *(u32x4*)(xs + (size_t)row * 1024 + colb + bj * HALF) = w; }
                }
                if (bj == 0) continue;
                if (gsn) { ss += __shfl_xor(ss, 16); ss += __shfl_xor(ss, 32); if (fq == 0) ssq[(size_t)row * 16 + u.pn * 4 + wc] = ss; }
            }
    }
};

template <class Epi>
__device__ __forceinline__ void gemm_phase(LAS unsigned char* lds, const Gemm g, const StaticOrder& S, const Epi& E) {
    const int tid = otid(), wid = __builtin_amdgcn_readfirstlane(tid >> 6), lane = tid & 63, wr = wid >> 2, wc = wid & 3, fr = lane & 15, fq = lane >> 4;
    const int K = g.K, nt = K / BK;
    unsigned voffA[2], voffB[2];
#pragma unroll
    for (int i = 0; i < 2; ++i) { int R, C; stage_rc(tid * 16 + i * 8192, R, C); const int Rb = (R & ~31) + perm32(R & 31);
        voffA[i] = (unsigned)(R * K + C) * 2u; voffB[i] = (unsigned)(Rb * K + C) * 2u; }
    const size_t kstep = (size_t)(BK * 2);
    const size_t hstep = (size_t)HALF * K * 2;
    const size_t tstep = 2 * hstep;
    const unsigned ldsw = (unsigned)wid * 1024u;
    const int aoff = lds_byte(wr * 64 + fr, fq * 8), boff = lds_byte(wc * 32 + fr, fq * 8);
#define PG8_SA(b, h) (((b) * 2 + (h)) * HTB)
#define PG8_SB(b, h) ((4 + (b) * 2 + (h)) * HTB)
#define PG8_STAGE(bufoff, gbase, voff) do { _Pragma("unroll") for (int _i = 0; _i < 2; ++_i) \
        __builtin_amdgcn_global_load_lds((const unsigned*)((const char*)(gbase) + (voff)[_i]), (LAS unsigned*)(lds + (bufoff) + ldsw + _i * 8192), 16, 0, 0); } while (0)
#define PG8_LDA(dst, b, h) do { _Pragma("unroll") for (int m = 0; m < 4; ++m) _Pragma("unroll") for (int k = 0; k < 2; ++k) dst[m][k] = *(const LAS bf16x8*)(lds + PG8_SA(b, h) + aoff + m * 2048 + k * 1024); } while (0)
#define PG8_LDB(dst, b, h) do { _Pragma("unroll") for (int n = 0; n < 2; ++n) _Pragma("unroll") for (int k = 0; k < 2; ++k) dst[n][k] = *(const LAS bf16x8*)(lds + PG8_SB(b, h) + boff + n * 2048 + k * 1024); } while (0)
#define PG8_MMA(ai, bj, At, Bt) do { __builtin_amdgcn_s_setprio(1); _Pragma("unroll") for (int m = 0; m < 4; ++m) _Pragma("unroll") for (int n = 0; n < 2; ++n) _Pragma("unroll") for (int k = 0; k < 2; ++k) \
        acc[ai][bj][m][n] = __builtin_amdgcn_mfma_f32_16x16x32_bf16(Bt[n][k], At[m][k], acc[ai][bj][m][n], 0, 0, 0); __builtin_amdgcn_s_setprio(0); } while (0)
#define PG8_WAIT_V(n) asm volatile("s_waitcnt vmcnt(" #n ")" ::: "memory")
#define PG8_WAIT_L(n) asm volatile("s_waitcnt lgkmcnt(" #n ")" ::: "memory")
#define PG8_BAR __builtin_amdgcn_s_barrier()
#define PG8_SCHED __builtin_amdgcn_sched_barrier(0)
    Unit cur, nxt; int ui = 0;
    if (!S.next(0, cur)) return;
    f32x4 acc[2][2][4][2];
#pragma unroll
    for (int a = 0; a < 2; ++a)
#pragma unroll
        for (int b = 0; b < 2; ++b)
#pragma unroll
            for (int m = 0; m < 4; ++m)
#pragma unroll
                for (int n = 0; n < 2; ++n) acc[a][b][m][n] = (f32x4){0.f, 0.f, 0.f, 0.f};
    bf16x8 At[4][2], B0[2][2], B1[2][2];
    const char* cA = (const char*)g.A + (size_t)cur.pm * tstep; const char* cB = (const char*)g.Bt + (size_t)cur.pn * tstep;
    PG8_STAGE(PG8_SB(0, 0), cB, voffB); PG8_STAGE(PG8_SB(0, 1), cB + hstep, voffB); PG8_STAGE(PG8_SA(0, 0), cA, voffA); PG8_STAGE(PG8_SA(0, 1), cA + hstep, voffA);
    if (wr == 1) PG8_BAR;
    PG8_WAIT_V(2); PG8_BAR;
    PG8_STAGE(PG8_SB(1, 0), cB + kstep, voffB); PG8_STAGE(PG8_SA(1, 0), cA + kstep, voffA); PG8_STAGE(PG8_SB(1, 1), cB + hstep + kstep, voffB);
    PG8_WAIT_V(6); PG8_BAR;
    for (;;) {
        const bool has_next = S.next(ui + 1, nxt);
        const char* nA = has_next ? (const char*)g.A + (size_t)nxt.pm * tstep : cA; const char* nB = has_next ? (const char*)g.Bt + (size_t)nxt.pn * tstep : cB;
        for (int t = 0; t < nt; t += 2) {
            const bool last = (t == nt - 2);
            const char* a1 = cA + (size_t)(t + 1) * kstep;
            const char* a2 = last ? nA : cA + (size_t)(t + 2) * kstep; const char* b2 = last ? nB : cB + (size_t)(t + 2) * kstep;
            const char* a3 = a2 + kstep; const char* b3 = b2 + kstep;
            PG8_LDB(B0, 0, 0); PG8_LDB(B1, 0, 1); PG8_SCHED; PG8_LDA(At, 0, 0); PG8_STAGE(PG8_SA(1, 1), a1 + hstep, voffA);
            PG8_WAIT_V(8); PG8_WAIT_L(0); PG8_BAR; PG8_MMA(0, 0, At, B0); PG8_MMA(0, 1, At, B1); PG8_BAR; PG8_SCHED;
            PG8_LDA(At, 0, 1); PG8_STAGE(PG8_SB(0, 0), b2, voffB); PG8_STAGE(PG8_SB(0, 1), b2 + hstep, voffB); PG8_STAGE(PG8_SA(0, 0), a2, voffA);
            PG8_WAIT_V(8); PG8_WAIT_L(0); PG8_BAR; PG8_MMA(1, 0, At, B0); PG8_MMA(1, 1, At, B1); PG8_BAR; PG8_SCHED;
            PG8_LDB(B0, 1, 0); PG8_LDB(B1, 1, 1); PG8_SCHED; PG8_LDA(At, 1, 0); PG8_STAGE(PG8_SA(0, 1), a2 + hstep, voffA);
            PG8_WAIT_V(8); PG8_WAIT_L(0); PG8_BAR; PG8_MMA(0, 0, At, B0); PG8_MMA(0, 1, At, B1); PG8_BAR; PG8_SCHED;
            PG8_LDA(At, 1, 1); PG8_STAGE(PG8_SB(1, 0), b3, voffB); PG8_STAGE(PG8_SB(1, 1), b3 + hstep, voffB); PG8_STAGE(PG8_SA(1, 0), a3, voffA);
            PG8_WAIT_V(8); PG8_WAIT_L(0); PG8_BAR; PG8_MMA(1, 0, At, B0); PG8_MMA(1, 1, At, B1); PG8_BAR; PG8_SCHED;
        }
        if (wr == 0) PG8_BAR;
        E(acc, cur, wr, wc, fr, fq);
        if (!has_next) break;
#pragma unroll
        for (int a = 0; a < 2; ++a)
#pragma unroll
            for (int b = 0; b < 2; ++b)
#pragma unroll
                for (int m = 0; m < 4; ++m)
#pragma unroll
                    for (int n = 0; n < 2; ++n) acc[a][b][m][n] = (f32x4){0.f, 0.f, 0.f, 0.f};
        cur = nxt; cA = nA; cB = nB; ++ui;
        if (wr == 1) PG8_BAR;
    }
    PG8_WAIT_V(0);
    PG8_BAR;
#undef PG8_SA
#undef PG8_SB
#undef PG8_STAGE
#undef PG8_LDA
#undef PG8_LDB
#undef PG8_MMA
#undef PG8_WAIT_V
#undef PG8_WAIT_L
#undef PG8_BAR
#undef PG8_SCHED
}
}

__device__ __forceinline__ void transpose_item(const float* W, int K, int N, bf16_t* WT, int row_off, LAS float* scr, int item, int lane) {
    const int nblk = N / 32, kb = item / nblk, nb = item % nblk, k0 = 64 * kb, n0 = 32 * nb;
    { float w[32];
#pragma unroll
      for (int i = 0; i < 32; ++i) w[i] = W[(size_t)(k0 + 2 * i + (lane >> 5)) * N + n0 + (lane & 31)];
#pragma unroll
      for (int i = 0; i < 32; ++i) scr[(2 * i + (lane >> 5)) * 33 + (lane & 31)] = w[i]; }
    asm volatile("s_waitcnt lgkmcnt(0)" ::: "memory");
    const int c = lane & 7;
#pragma unroll
    for (int j = 0; j < 4; ++j) { const int n = (lane >> 3) + 8 * j; const LAS float* s = scr + (8 * c) * 33 + n;
        u32x4 o; o.x = pk2(s[0 * 33], s[1 * 33]); o.y = pk2(s[2 * 33], s[3 * 33]); o.z = pk2(s[4 * 33], s[5 * 33]); o.w = pk2(s[6 * 33], s[7 * 33]);
        *(u32x4*)(WT + (size_t)(row_off + n0 + n) * K + k0 + 8 * c) = o; }
    asm volatile("s_waitcnt lgkmcnt(0)" ::: "memory");
}
__device__ __forceinline__ void do_transposes(const Args& a, LAS unsigned char* lds, int job_lo, int job_hi, int ml, int wblk, int nblk) {
    const int tid = otid(), lane = tid & 63, wave = tid >> 6;
    const int gw = wblk * 8 + wave, NGW = nblk * 8;
    LAS float* scr = (LAS float*)(lds + wave * 16384);
    unsigned char* ws = a.ws;
    int base = 0;
    for (int job = job_lo; job < job_hi; ++job) {
        const float* W; int K, N, roff = 0; bf16_t* dst;
        switch (job) {
            case 0: W = a.in[12]; K = 1024; N = 3072; dst = (bf16_t*)(ws + WS_W + OFF_SCIN0); break;
            case 1: W = a.in[15]; K = 1024; N = 1024; dst = (bf16_t*)(ws + WS_W + OFF_SCOUT0); break;
            case 2: W = a.in[12] + (size_t)1024 * 3072; K = 1024; N = 3072; dst = (bf16_t*)(ws + WS_W + OFF_SCIN1); break;
            case 3: W = a.in[15] + (size_t)1024 * 1024; K = 1024; N = 1024; dst = (bf16_t*)(ws + WS_W + OFF_SCOUT1); break;
            case 4: W = a.in[25]; K = 1024; N = 3072; dst = (bf16_t*)(ws + WS_W + OFF_HYIN); break;
            case 5: W = a.in[37]; K = 1024; N = 1024; dst = (bf16_t*)(ws + WS_W + OFF_HYOUT); break;
            case 6: W = a.in[24]; K = 1024; N = 1024; dst = (bf16_t*)(ws + WS_W + OFF_WO); break;
            case 7: W = a.in[16]; K = 1024; N = 384; dst = (bf16_t*)(ws + WS_W + OFF_DQKV); break;
            case 8: W = a.in[19]; K = 1024; N = 288; dst = (bf16_t*)(ws + WS_W + OFF_DQKV); roff = 384; break;
            case 9: W = a.in[18]; K = 384; N = 1536; dst = (bf16_t*)(ws + WS_W + OFF_WUQ); break;
            case 10: W = a.in[21]; K = 256; N = 2048; dst = (bf16_t*)(ws + WS_W + OFF_WUKV); break;
            case 11: W = a.in[10] + (size_t)ml * 1024 * 4096; K = 1024; N = 4096; dst = (bf16_t*)(ws + WS_MLP1); break;
            default: W = a.in[11] + (size_t)ml * 4096 * 1024; K = 4096; N = 1024; dst = (bf16_t*)(ws + WS_MLP2); break;
        }
        const int items = (K / 64) * (N / 32);
        int start = (gw - base) % NGW; if (start < 0) start += NGW;
        for (int it = start; it < items; it += NGW) transpose_item(W, K, N, dst, roff, scr, it, lane);
        base = (base + items) % NGW;
    }
}

__device__ __forceinline__ void gemv_unit(LAS float* lv, LAS float* red, const float* W, int N, int n0, float* out, int ostride, const float* badd) {
    const int tid = otid(), kg = tid >> 6, cl = tid & 63, n = n0 + cl;
    float a0 = 0.f, a1 = 0.f, a2 = 0.f, a3 = 0.f, a4 = 0.f;
    if (n < N) {
        const float* wp = W + (size_t)(kg * 128) * N + n;
        const LAS float* v = lv + kg * 128;
#pragma unroll 1
        for (int k0 = 0; k0 < 128; k0 += 32) {
            float w[32];
#pragma unroll
            for (int k = 0; k < 32; ++k) w[k] = wp[(size_t)(k0 + k) * N];
#pragma unroll
            for (int k = 0; k < 32; ++k) { a0 += v[k0 + k] * w[k]; a1 += v[1024 + k0 + k] * w[k]; a2 += v[2048 + k0 + k] * w[k]; a3 += v[3072 + k0 + k] * w[k]; a4 += v[4096 + k0 + k] * w[k]; }
        }
    }
    red[(kg * 5 + 0) * 64 + cl] = a0; red[(kg * 5 + 1) * 64 + cl] = a1; red[(kg * 5 + 2) * 64 + cl] = a2; red[(kg * 5 + 3) * 64 + cl] = a3; red[(kg * 5 + 4) * 64 + cl] = a4;
    __syncthreads();
    if (tid < 320) { const int ci = tid >> 6; float s = 0.f;
#pragma unroll
        for (int q = 0; q < 8; ++q) s += red[(q * 5 + ci) * 64 + cl];
        if (n < N) out[(size_t)ci * ostride + n] = s + (badd ? badd[n] : 0.f); }
    __syncthreads();
}

__device__ __forceinline__ void phase0(const Args& a, LAS unsigned char* lds) {
    const int tid = otid(), bid = obid(), lane = tid & 63, wave = tid >> 6, G = ogrid();
    const int gw = bid * 8 + wave, NGW = G * 8, gt = bid * 512 + tid, GT = G * 512;
    unsigned char* ws = a.ws;
    do_transposes(a, lds, 0, 13, 0, obid(), ogrid());
    { u32x4* p = (u32x4*)(ws + WS_W + OFF_DQKV + (size_t)672 * 1024 * 2); for (int i = gt; i < 12288; i += GT) p[i] = (u32x4){0u, 0u, 0u, 0u}; }
    { const float* w0 = a.in[28]; const float* b0 = a.in[29]; const float* w1 = a.in[30]; const float* b1 = a.in[31]; const float* w2 = a.in[32]; const float* b2 = a.in[33]; const float frq = a.in[35][lane];
      float* A3 = (float*)(ws + WS_A3);
      for (int pos = gw; pos < 4352; pos += NGW) {
          const int n = pos < 256 ? 256 : 4096, t = pos < 256 ? pos : pos - 256;
          const float t01 = (float)t / (float)(n - 1), w = 6.283185307179586f * (float)t / (float)n;
          float z = 0.f;
          if (lane == 0) z = t01;
          else if (lane <= 32) { const int i = (lane - 1) & 15; const float fb = 1e-4f + (15.0f - 1e-4f) * (float)i / 15.0f; z = lane <= 16 ? cosf(fb * w) : -sinf(fb * w); }
          float acc = b0[lane];
#pragma unroll
          for (int e = 0; e < 33; ++e) acc += __shfl(z, e) * w0[e * 64 + lane];
          const float h1 = sinf(frq * acc);
          acc = b1[lane];
#pragma unroll 16
          for (int k = 0; k < 64; ++k) acc += __shfl(h1, k) * w1[k * 64 + lane];
          const float h2 = sinf(frq * acc);
          acc = b2[lane];
#pragma unroll 16
          for (int k = 0; k < 64; ++k) acc += __shfl(h2, k) * w2[k * 64 + lane];
          A3[(size_t)pos * 64 + lane] = sinf(frq * acc);
      } }
    __syncthreads();
    LAS float* lv = (LAS float*)lds; LAS float* red = (LAS float*)(lds + 20480);
    for (int i = tid; i < 5120; i += 512) { const int ci = i >> 10, k = i & 1023; const float c = ci == 0 ? a.in[5][k] : a.in[4][(ci - 1) * 1024 + k]; lv[i] = c / (1.f + expf(-c)); }
    __syncthreads();
    float* MODV = (float*)(ws + WS_MODV);
    for (int u = bid; u < 4 * 96; u += G) { const int l = u / 96, n0 = (u % 96) * 64;
        gemv_unit(lv, red, a.in[8] + (size_t)l * 1024 * 6144, 6144, n0, MODV + (size_t)l * 5 * 6144, 6144, a.in[9] + (size_t)l * 6144); }
}

__device__ __forceinline__ void hfb_unit(const Args& a, LAS unsigned char* lds, int unit);
__device__ __forceinline__ void phase1(const Args& a, LAS unsigned char* lds) {
    const int tid = otid(), bid = obid(), lane = tid & 63, wave = tid >> 6, G = ogrid();
    const int gw = bid * 8 + wave, NGW = G * 8, gt = bid * 512 + tid, GT = G * 512;
    unsigned char* ws = a.ws;
    const float* MODV = (const float*)(ws + WS_MODV);
    float* GS = (float*)(ws + WS_GS);
    for (int i = gt; i < 8 * 5 * 1024; i += GT) { const int k = i & 1023, ci = (i >> 10) % 5, lw = i / 5120, l = lw >> 1, w = lw & 1;
        const float gn = (w ? a.in[7] : a.in[6])[l * 1024 + k]; GS[i] = gn * (1.f + MODV[(size_t)(l * 5 + ci) * 6144 + (w ? 4 : 1) * 1024 + k]); }
    { float* BZ = (float*)(ws + WS_BIAS) + B_DQKV; for (int i = gt; i < 5 * 96; i += GT) BZ[(i / 96) * 768 + 672 + (i % 96)] = 0.f; }
    bf16_t* XS = (bf16_t*)(ws + WS_XS); float* SSQ = (float*)(ws + WS_SSQ);
    for (int m0 = gw; m0 < M; m0 += 4 * NGW) {
        f32x4 v[4][4];
#pragma unroll
        for (int q = 0; q < 4; ++q) { const int m = m0 + q * NGW; if (m < M) { const float* xr = m < MP ? a.in[0] + (size_t)m * D : a.in[1] + (size_t)(m - MP) * D;
#pragma unroll
            for (int j = 0; j < 4; ++j) v[q][j] = ((const f32x4*)xr)[lane + 64 * j]; } }
#pragma unroll
        for (int q = 0; q < 4; ++q) { const int m = m0 + q * NGW; if (m < M) {
            const int ci = m < MP ? 0 : 1 + ((m - MP) >> 12);
            const float* sc = MODV + (size_t)ci * 6144 + 1024;
            float s = 0.f;
#pragma unroll
            for (int j = 0; j < 4; ++j) s += (v[q][j].x * v[q][j].x + v[q][j].y * v[q][j].y) + (v[q][j].z * v[q][j].z + v[q][j].w * v[q][j].w);
            s = wave_sum(s);
#pragma unroll
            for (int j = 0; j < 4; ++j) {
                const f32x4 gn = ((const f32x4*)a.in[6])[lane + 64 * j]; const f32x4 sv = ((const f32x4*)sc)[lane + 64 * j];
                const f32x4 y = v[q][j] * gn * (sv + 1.f);
                u32x2 o; o.x = pk2(y.x, y.y); o.y = pk2(y.z, y.w);
                ((u32x2*)(XS + (size_t)m * D))[lane + 64 * j] = o;
            }
            if (lane < 16) SSQ[(size_t)m * 16 + lane] = lane == 0 ? s : 0.f; } }
    }
    __syncthreads();
    LAS float* lv = (LAS float*)lds; LAS float* red = (LAS float*)(lds + 20480);
    float* BIAS = (float*)(ws + WS_BIAS);
    for (int u = bid; u < 411; u += G) {
        int r = u; const float* W; int N, l, wh, ostride; float* out;
        if (r < 48) { W = a.in[12]; N = 3072; l = 0; wh = 0; out = BIAS + B_IN0; ostride = 3072; }
        else if ((r -= 48) < 64) { W = a.in[10]; N = 4096; l = 0; wh = 1; out = BIAS + B_M0; ostride = 4096; }
        else if ((r -= 64) < 6) { W = a.in[16]; N = 384; l = 1; wh = 0; out = BIAS + B_DQKV; ostride = 768; }
        else if ((r -= 6) < 5) { W = a.in[19]; N = 288; l = 1; wh = 0; out = BIAS + B_DQKV + 384; ostride = 768; }
        else if ((r -= 5) < 64) { W = a.in[10] + (size_t)1 * 1024 * 4096; N = 4096; l = 1; wh = 1; out = BIAS + B_M1; ostride = 4096; }
        else if ((r -= 64) < 48) { W = a.in[25]; N = 3072; l = 2; wh = 0; out = BIAS + B_HY; ostride = 3072; }
        else if ((r -= 48) < 64) { W = a.in[10] + (size_t)2 * 1024 * 4096; N = 4096; l = 2; wh = 1; out = BIAS + B_M2; ostride = 4096; }
        else if ((r -= 64) < 48) { W = a.in[12] + (size_t)1024 * 3072; N = 3072; l = 3; wh = 0; out = BIAS + B_IN3; ostride = 3072; }
        else { r -= 48; W = a.in[10] + (size_t)3 * 1024 * 4096; N = 4096; l = 3; wh = 1; out = BIAS + B_M3; ostride = 4096; }
        for (int i = tid; i < 5120; i += 512) { const int ci = i >> 10, k = i & 1023; lv[i] = MODV[(size_t)(l * 5 + ci) * 6144 + (wh ? 3 : 0) * 1024 + k]; }
        __syncthreads();
        gemv_unit(lv, red, W, N, r * 64, out, ostride, nullptr);
    }
    __syncthreads();
    for (int u = bid; u < 68 * 16; u += G) hfb_unit(a, lds, u);
}

__device__ __forceinline__ void sc_conv_phase(const Args& a, int j) {
    const int gt = obid() * 512 + otid(), GT = ogrid() * 512;
    const bf16_t* U3 = (const bf16_t*)(a.ws + WS_AR); bf16_t* Z = (bf16_t*)(a.ws + WS_Z);
    const float* cw = a.in[13] + (size_t)j * 3 * 1024; const float* cb = a.in[14] + (size_t)j * 1024;
    for (int it = gt; it < (M / 8) * 128; it += GT) {
        const int cgp = it & 127, rb = it >> 7, c = cgp * 8, row0 = rb * 8;
        const int L = row0 < MP ? 256 : 4096, t0 = row0 < MP ? (row0 & 255) : ((row0 - MP) & 4095);
        float w0[8], w1[8], w2[8], bb[8];
#pragma unroll
        for (int i = 0; i < 8; i += 4) { const f32x4 a0 = *(const f32x4*)(cw + c + i), a1 = *(const f32x4*)(cw + 1024 + c + i), a2 = *(const f32x4*)(cw + 2048 + c + i), a3 = *(const f32x4*)(cb + c + i);
#pragma unroll
            for (int e = 0; e < 4; ++e) { w0[i + e] = a0[e]; w1[i + e] = a1[e]; w2[i + e] = a2[e]; bb[i + e] = a3[e]; } }
        u32x4 rx[10], ry[10], rg[8];
#pragma unroll
        for (int q = 0; q < 10; ++q) { const int tq = t0 - 1 + q; const int rr = (tq >= 0 && tq < L) ? row0 - 1 + q : row0;
            rx[q] = *(const u32x4*)(U3 + (size_t)rr * 3072 + 1024 + c); ry[q] = *(const u32x4*)(U3 + (size_t)rr * 3072 + 2048 + c); }
#pragma unroll
        for (int r = 0; r < 8; ++r) rg[r] = *(const u32x4*)(U3 + (size_t)(row0 + r) * 3072 + c);
        float prev[8], cur[8], nxt[8];
        auto prod = [&](int q, float (&p)[8]) { float x[8], y[8]; unpack8(rx[q], x); unpack8(ry[q], y); const int tq = t0 - 1 + q; const float m = (tq >= 0 && tq < L) ? 1.f : 0.f;
#pragma unroll
            for (int i = 0; i < 8; ++i) p[i] = x[i] * y[i] * m; };
        prod(0, prev); prod(1, cur);
#pragma unroll
        for (int r = 0; r < 8; ++r) {
            prod(r + 2, nxt);
            float bg[8], o[8]; unpack8(rg[r], bg);
#pragma unroll
            for (int i = 0; i < 8; ++i) { o[i] = bg[i] * (w0[i] * prev[i] + w1[i] * cur[i] + w2[i] * nxt[i] + bb[i]); prev[i] = cur[i]; cur[i] = nxt[i]; }
            *(u32x4*)(Z + (size_t)(row0 + r) * 1024 + c) = pack8(o);
        }
    }
}

__device__ __forceinline__ void mla_latent_phase(const Args& a) {
    const int tid_ = otid(), lane = tid_ & 63, wave = tid_ >> 6, gw = obid() * 8 + wave, NGW = ogrid() * 8;
    const float* QKVL = (const float*)(a.ws + WS_AR + AR_QKVL);
    bf16_t* CQ = (bf16_t*)(a.ws + WS_AR + AR_CQ); bf16_t* CKV = (bf16_t*)(a.ws + WS_AR + AR_CKV); float* KPE = (float*)(a.ws + WS_AR + AR_KPE);
    const float* qg = a.in[17]; const float* kvg = a.in[20];
    { const int gt = obid() * 512 + tid_, GT = ogrid() * 512;
      const f32x4* src = (const f32x4*)a.in[2]; u32x2* dst = (u32x2*)(CKV + (size_t)M * 256);
      for (int i = gt; i < NCACHE * 256 / 4; i += GT) { const f32x4 v = src[i]; u32x2 o; o.x = pk2(v.x, v.y); o.y = pk2(v.z, v.w); dst[i] = o; }
      const f32x4* s2 = (const f32x4*)a.in[3]; f32x4* d2 = (f32x4*)(KPE + (size_t)M * 32);
      for (int i = gt; i < NCACHE * 32 / 4; i += GT) d2[i] = s2[i]; }
    for (int m0 = gw; m0 < M; m0 += 4 * NGW) {
        f32x2 qv[4][3]; f32x4 kvv[4]; float pev[4];
#pragma unroll
        for (int q4 = 0; q4 < 4; ++q4) { const int m = m0 + q4 * NGW; if (m < M) { const float* r = QKVL + (size_t)m * 768;
#pragma unroll
            for (int j = 0; j < 3; ++j) qv[q4][j] = *(const f32x2*)(r + 2 * lane + 128 * j);
            kvv[q4] = *(const f32x4*)(r + 384 + 4 * lane); pev[q4] = lane < 32 ? r[640 + lane] : 0.f; } }
#pragma unroll
        for (int q4 = 0; q4 < 4; ++q4) { const int m = m0 + q4 * NGW; if (m < M) {
            float s = 0.f;
#pragma unroll
            for (int j = 0; j < 3; ++j) s += qv[q4][j].x * qv[q4][j].x + qv[q4][j].y * qv[q4][j].y;
            const f32x4 kv = kvv[q4];
            float s2 = (kv.x * kv.x + kv.y * kv.y) + (kv.z * kv.z + kv.w * kv.w);
            const float pe = pev[q4];
            s = wave_sum(s); s2 = wave_sum(s2);
            const float rq = rsqrtf(s * (1.0f / 384.0f) + EPS), rk = rsqrtf(s2 * (1.0f / 256.0f) + EPS);
#pragma unroll
            for (int j = 0; j < 3; ++j) { const f32x2 gq = *(const f32x2*)(qg + 2 * lane + 128 * j); *(unsigned*)(CQ + (size_t)m * 384 + 2 * lane + 128 * j) = pk2(qv[q4][j].x * rq * gq.x, qv[q4][j].y * rq * gq.y); }
            const f32x4 gk = *(const f32x4*)(kvg + 4 * lane); const f32x4 kn = kv * rk * gk;
            u32x2 o; o.x = pk2(kn.x, kn.y); o.y = pk2(kn.z, kn.w); *(u32x2*)(CKV + (size_t)m * 256 + 4 * lane) = o;
            if (m < MP) *(f32x4*)(a.out + OUT_CKV + (size_t)m * 256 + 4 * lane) = kn;
            if (lane < 32) { KPE[(size_t)m * 32 + lane] = pe; if (m < MP) a.out[OUT_KPE + (size_t)m * 32 + lane] = pe; } } }
    }
}

__device__ __forceinline__ void normrope(float (&x)[16], float (&tl)[8], const float* gain, int j, bool rope, int t, float scale, const LAS f32x2* rt) {
    float ss = 0.f;
#pragma unroll
    for (int i = 0; i < 16; ++i) ss += x[i] * x[i];
#pragma unroll
    for (int i = 0; i < 8; ++i) ss += tl[i] * tl[i];
    ss += __shfl_xor(ss, 1); ss += __shfl_xor(ss, 2);
    const float rs = rsqrtf(ss * (1.0f / 96.0f) + EPS) ;
#pragma unroll
    for (int i = 0; i < 16; i += 4) { const f32x4 gq = *(const f32x4*)(gain + j * 16 + i);
#pragma unroll
        for (int e = 0; e < 4; ++e) x[i + e] = x[i + e] * rs * gq[e] * scale; }
#pragma unroll
    for (int i = 0; i < 8; i += 4) { const f32x4 gq = *(const f32x4*)(gain + 64 + j * 8 + i);
#pragma unroll
        for (int e = 0; e < 4; ++e) tl[i + e] = tl[i + e] * rs * gq[e]; }
    if (rope) {
        const int pos = (j < 2) ? (t >> 6) : (t & 63);
#pragma unroll
        for (int i = 0; i < 8; ++i) {
            const float partner = __shfl_xor(tl[i], 1);
            const f32x2 cssn = rt[pos * 8 + i];
            tl[i] = (j & 1) ? (tl[i] * cssn.x + partner * cssn.y) : (tl[i] * cssn.x - partner * cssn.y);
        }
    }
#pragma unroll
    for (int i = 0; i < 8; ++i) tl[i] *= scale;
}
__device__ __forceinline__ void kq_finalize_phase(const Args& a, LAS unsigned char* lds) {
    const int tid_ = otid(), lane = tid_ & 63, wave = tid_ >> 6, gw = obid() * 8 + wave, NGW = ogrid() * 8;
    const int h = lane >> 2, j = lane & 3;
    bf16_t* KV = (bf16_t*)(a.ws + WS_AR + AR_KV); const float* KPE = (const float*)(a.ws + WS_AR + AR_KPE); bf16_t* Q = (bf16_t*)(a.ws + WS_XS);
    const float QSCALE = 0.10206207261596575f * 1.4426950408889634f;
    LAS f32x2* rt = (LAS f32x2*)(lds + 135168);
    { const int pos = tid_ >> 3, i = tid_ & 7; const float ang = (float)pos * exp2f(-(float)i * 1.6609640474436813f); rt[tid_] = (f32x2){cosf(ang), sinf(ang)}; }
    __syncthreads();
    constexpr int RB = 4;
    for (int it0 = gw; it0 < MKV; it0 += RB * NGW) {
        u32x4 xa[RB], xb[RB]; f32x4 pa[RB], pb[RB];
#pragma unroll
        for (int q = 0; q < RB; ++q) { const int r = it0 + q * NGW; if (r < MKV) { const bf16_t* base = KV + (size_t)r * 2560 + h * 160;
            xa[q] = *(const u32x4*)(base + j * 16); xb[q] = *(const u32x4*)(base + j * 16 + 8);
            pa[q] = *(const f32x4*)(KPE + (size_t)r * 32 + j * 8); pb[q] = *(const f32x4*)(KPE + (size_t)r * 32 + j * 8 + 4); } }
#pragma unroll
        for (int q = 0; q < RB; ++q) { const int r = it0 + q * NGW; if (r < MKV) { bf16_t* base = KV + (size_t)r * 2560 + h * 160;
            float x[16], tl[8], t8[8];
            unpack8(xa[q], t8);
#pragma unroll
            for (int i = 0; i < 8; ++i) x[i] = t8[i];
            unpack8(xb[q], t8);
#pragma unroll
            for (int i = 0; i < 8; ++i) x[8 + i] = t8[i];
            tl[0] = pa[q].x; tl[1] = pa[q].y; tl[2] = pa[q].z; tl[3] = pa[q].w; tl[4] = pb[q].x; tl[5] = pb[q].y; tl[6] = pb[q].z; tl[7] = pb[q].w;
            normrope(x, tl, a.in[23], j, (r >= MP) && (r < M), (r - MP) & 4095, 1.0f, rt);
            float o8[8];
#pragma unroll
            for (int i = 0; i < 8; ++i) o8[i] = x[i];
            *(u32x4*)(base + j * 16) = pack8(o8);
#pragma unroll
            for (int i = 0; i < 8; ++i) o8[i] = x[8 + i];
            *(u32x4*)(base + j * 16 + 8) = pack8(o8);
            *(u32x4*)(base + 128 + j * 8) = pack8(tl); } }
    }
}

__device__ __forceinline__ void k_finalize_own_units(const Args& a, LAS unsigned char* lds, const pg8::StaticOrder& S) {
    const int tid = otid(), j = tid & 3;
    bf16_t* KV = (bf16_t*)(a.ws + WS_AR + AR_KV); const float* KPE = (const float*)(a.ws + WS_AR + AR_KPE);
    LAS f32x2* rt = (LAS f32x2*)(lds + 135168);
    { const int pos = tid >> 3, i = tid & 7; const float ang = (float)pos * exp2f(-(float)i * 1.6609640474436813f); rt[tid] = (f32x2){cosf(ang), sinf(ang)}; }
    asm volatile("s_waitcnt vmcnt(0)" ::: "memory");
    __syncthreads();
    pg8::Unit u;
    for (int i = 0; S.next(i, u); ++i) {
        unsigned long long xr[4][4]; f32x4 pa[4], pb[4];
#pragma unroll
        for (int it = 0; it < 4; ++it) { const int pi = (it * 512 + tid) >> 2, r = u.pm * 256 + (pi >> 1), h = 2 * u.pn + (pi & 1);
            const unsigned long long* base = (const unsigned long long*)(KV + (size_t)r * 2560 + h * 160 + j * 16);
#pragma unroll
            for (int q = 0; q < 4; ++q) xr[it][q] = __hip_atomic_load(base + q, __ATOMIC_RELAXED, __HIP_MEMORY_SCOPE_AGENT);
            pa[it] = *(const f32x4*)(KPE + (size_t)r * 32 + j * 8); pb[it] = *(const f32x4*)(KPE + (size_t)r * 32 + j * 8 + 4); }
#pragma unroll
        for (int it = 0; it < 4; ++it) { const int pi = (it * 512 + tid) >> 2, r = u.pm * 256 + (pi >> 1), h = 2 * u.pn + (pi & 1);
            bf16_t* base = KV + (size_t)r * 2560 + h * 160;
            float x[16], tl[8], t8[8];
            unpack8((u32x4){(unsigned)xr[it][0], (unsigned)(xr[it][0] >> 32), (unsigned)xr[it][1], (unsigned)(xr[it][1] >> 32)}, t8);
#pragma unroll
            for (int e = 0; e < 8; ++e) x[e] = t8[e];
            unpack8((u32x4){(unsigned)xr[it][2], (unsigned)(xr[it][2] >> 32), (unsigned)xr[it][3], (unsigned)(xr[it][3] >> 32)}, t8);
#pragma unroll
            for (int e = 0; e < 8; ++e) x[8 + e] = t8[e];
            tl[0] = pa[it].x; tl[1] = pa[it].y; tl[2] = pa[it].z; tl[3] = pa[it].w; tl[4] = pb[it].x; tl[5] = pb[it].y; tl[6] = pb[it].z; tl[7] = pb[it].w;
            normrope(x, tl, a.in[23], j, (r >= MP) && (r < M), (r - MP) & 4095, 1.0f, rt);
            float o8[8];
#pragma unroll
            for (int e = 0; e < 8; ++e) o8[e] = x[e];
            *(u32x4*)(base + j * 16) = pack8(o8);
#pragma unroll
            for (int e = 0; e < 8; ++e) o8[e] = x[8 + e];
            *(u32x4*)(base + j * 16 + 8) = pack8(o8);
            *(u32x4*)(base + 128 + j * 8) = pack8(tl); }
    }
}

__device__ __forceinline__ void v_transpose_phase(const Args& a, LAS unsigned char* lds) {
    const int tid = otid(), lane = tid & 63, wave = tid >> 6, gw = obid() * 8 + wave, NGW = ogrid() * 8;
    bf16_t* KV = (bf16_t*)(a.ws + WS_AR + AR_KV);
    LAS unsigned short* scr = (LAS unsigned short*)(lds + wave * 16384);
    const int r8 = lane >> 3, c8 = lane & 7;
    for (int it = gw; it < (MKV / 64) * 16; it += NGW) {
        const int kb = it >> 4, h = it & 15;
        bf16_t* base = KV + (size_t)(kb * 64) * 2560 + h * 160 + 64;
        u32x4 v[8];
#pragma unroll
        for (int i = 0; i < 8; ++i) v[i] = *(const u32x4*)(base + (size_t)(r8 + 8 * i) * 2560 + c8 * 8);
#pragma unroll
        for (int i = 0; i < 8; ++i) { LAS unsigned* p = (LAS unsigned*)(scr + (r8 + 8 * i) * 66 + c8 * 8); p[0] = v[i].x; p[1] = v[i].y; p[2] = v[i].z; p[3] = v[i].w; }
        asm volatile("s_waitcnt lgkmcnt(0)" ::: "memory");
#pragma unroll
        for (int i = 0; i < 8; ++i) { const int d = r8 + 8 * i; const LAS unsigned short* q = scr + (c8 * 8) * 66 + d;
            u32x4 o; o.x = (unsigned)q[0] | ((unsigned)q[66] << 16); o.y = (unsigned)q[2 * 66] | ((unsigned)q[3 * 66] << 16);
            o.z = (unsigned)q[4 * 66] | ((unsigned)q[5 * 66] << 16); o.w = (unsigned)q[6 * 66] | ((unsigned)q[7 * 66] << 16);
            *(u32x4*)(base + (size_t)d * 2560 + c8 * 8) = o; }
        asm volatile("s_waitcnt lgkmcnt(0)" ::: "memory");
    }
}

template <int OFF> __device__ __forceinline__ u32x2 tr_read(unsigned vb) {
    u32x2 r; asm volatile("ds_read_b64_tr_b16 %0, %1 offset:%2" : "=&v"(r) : "v"(vb), "i"(OFF) : "memory"); return r;
}
constexpr int KS_PITCH = 208, VT_PITCH = 144, VT_OFF = 64 * KS_PITCH, ST_BYTES = 64 * KS_PITCH + 64 * VT_PITCH, ROPE_OFF = 65536;
__device__ __forceinline__ void attn_unit(const Args& a, LAS unsigned char* lds, int u, float kbound) {
    const int tid = otid(), lane = tid & 63, wave = tid >> 6, fr = lane & 15, fq = lane >> 4;
    const bf16_t* KV = (const bf16_t*)(a.ws + WS_AR + AR_KV); const bf16_t* Q = (const bf16_t*)(a.ws + WS_XS); bf16_t* AO = (bf16_t*)(a.ws + WS_AR + AR_AO);
    int b, h, row0, nt; bool smp;
    if (u < 1024) { smp = true; const int bh = u >> 4, qb = u & 15; b = bh >> 4; h = bh & 15; row0 = MP + b * 4096 + qb * 256; nt = 72; }
    else { smp = false; const int v = u - 1024; b = v >> 4; h = v & 15; row0 = b * 256; nt = 4; }
    bf16x8 qf[2][3]; float mb[2];
    const float* qg = a.in[22];
    const LAS f32x2* rt = (const LAS f32x2*)(lds + ROPE_OFF);
    const float QSCALE = 0.10206207261596575f * 1.4426950408889634f;
#pragma unroll
    for (int qt = 0; qt < 2; ++qt) {
        const int row = row0 + wave * 32 + qt * 16 + fr;
        float f[3][8]; float ss = 0.f;
#pragma unroll
        for (int ks = 0; ks < 3; ++ks) { unpack8(*(const u32x4*)(Q + (size_t)row * 1536 + h * 96 + ks * 32 + fq * 8), f[ks]);
#pragma unroll
            for (int i = 0; i < 8; ++i) ss += f[ks][i] * f[ks][i]; }
        ss += __shfl_xor(ss, 16); ss += __shfl_xor(ss, 32);
        const float rs = rsqrtf(ss * (1.0f / 96.0f) + EPS);
#pragma unroll
        for (int ks = 0; ks < 3; ++ks) { const f32x4 g0 = *(const f32x4*)(qg + ks * 32 + fq * 8), g1 = *(const f32x4*)(qg + ks * 32 + fq * 8 + 4);
#pragma unroll
            for (int i = 0; i < 4; ++i) { f[ks][i] *= rs * g0[i]; f[ks][4 + i] *= rs * g1[i]; } }
        if (smp) {
            const int t = (row - MP) & 4095, pos = (fq < 2) ? (t >> 6) : (t & 63);
#pragma unroll
            for (int i = 0; i < 8; ++i) { const float partner = __shfl_xor(f[2][i], 16); const f32x2 cssn = rt[pos * 8 + i];
                f[2][i] = (fq & 1) ? (f[2][i] * cssn.x + partner * cssn.y) : (f[2][i] * cssn.x - partner * cssn.y); }
        }
        float s2 = 0.f;
#pragma unroll
        for (int ks = 0; ks < 3; ++ks) {
#pragma unroll
            for (int i = 0; i < 8; ++i) f[ks][i] *= QSCALE;
            const u32x4 w = pack8(f[ks]); qf[qt][ks] = __builtin_bit_cast(bf16x8, w);
            float r8[8]; unpack8(w, r8);
#pragma unroll
            for (int i = 0; i < 8; ++i) s2 += r8[i] * r8[i]; }
        s2 += __shfl_xor(s2, 16); s2 += __shfl_xor(s2, 32);
        mb[qt] = sqrtf(s2) * kbound;
    }
    f32x4 O[4][2]; float lrun[2];
#pragma unroll
    for (int dt = 0; dt < 4; ++dt)
#pragma unroll
        for (int qt = 0; qt < 2; ++qt) O[dt][qt] = (f32x4){0.f, 0.f, 0.f, 0.f};
    lrun[0] = lrun[1] = 0.f;
    const int kkey0 = tid / 12, kch0 = tid % 12, kkey1 = (tid + 512) / 12, kch1 = (tid + 512) % 12;
    const int kco0 = kch0 < 8 ? kch0 * 8 : 128 + (kch0 - 8) * 8, kco1 = kch1 < 8 ? kch1 * 8 : 128 + (kch1 - 8) * 8;
    const int vd = tid >> 3, vch = tid & 7;
    u32x4 kr0, kr1 = (u32x4){0u, 0u, 0u, 0u}, vr;
    auto tile_row = [&](int jt) -> int { return smp ? (jt < 64 ? MP + b * 4096 + jt * 64 : M + b * 512 + (jt - 64) * 64) : b * 256 + jt * 64; };
    auto gload = [&](int jt) { const int kr = tile_row(jt);
        kr0 = *(const u32x4*)(KV + (size_t)(kr + kkey0) * 2560 + h * 160 + kco0);
        if (tid < 256) kr1 = *(const u32x4*)(KV + (size_t)(kr + kkey1) * 2560 + h * 160 + kco1);
        vr = *(const u32x4*)(KV + (size_t)(kr + vd) * 2560 + h * 160 + 64 + vch * 8); };
    auto swrite = [&](int st) { LAS unsigned char* sb = lds + st * ST_BYTES;
        *(LAS u32x4*)(sb + kkey0 * KS_PITCH + kch0 * 16) = kr0;
        if (tid < 256) *(LAS u32x4*)(sb + kkey1 * KS_PITCH + kch1 * 16) = kr1;
        *(LAS u32x4*)(sb + VT_OFF + vd * VT_PITCH + vch * 16) = vr; };
    gload(0); swrite(0);
    __syncthreads();
    for (int jt = 0; jt < nt; ++jt) {
        const LAS unsigned char* sb = lds + (jt & 1) * ST_BYTES;
        if (jt + 1 < nt) gload(jt + 1);
        bf16x8 kf[3][4];
#pragma unroll
        for (int ks = 0; ks < 3; ++ks)
#pragma unroll
            for (int kt = 0; kt < 4; ++kt) kf[ks][kt] = *(const LAS bf16x8*)(sb + (kt * 16 + fr) * KS_PITCH + ks * 64 + fq * 16);
        __builtin_amdgcn_sched_barrier(0);
        f32x4 S[4][2];
#pragma unroll
        for (int kt = 0; kt < 4; ++kt)
#pragma unroll
            for (int qt = 0; qt < 2; ++qt) S[kt][qt] = (f32x4){-mb[qt], -mb[qt], -mb[qt], -mb[qt]};
#pragma unroll
        for (int ks = 0; ks < 3; ++ks)
#pragma unroll
            for (int kt = 0; kt < 4; ++kt)
#pragma unroll
                for (int qt = 0; qt < 2; ++qt) S[kt][qt] = __builtin_amdgcn_mfma_f32_16x16x32_bf16(kf[ks][kt], qf[qt][ks], S[kt][qt], 0, 0, 0);
        u32x2 vlo[2][4], vhi[2][4];
        { const unsigned vb = (unsigned)(size_t)(sb + VT_OFF) + (unsigned)((fq * 4 + (fr >> 2)) * VT_PITCH + (fr & 3) * 8);
          vlo[0][0] = tr_read<0 * 32>(vb);  vhi[0][0] = tr_read<16 * VT_PITCH + 0 * 32>(vb);
          vlo[0][1] = tr_read<1 * 32>(vb);  vhi[0][1] = tr_read<16 * VT_PITCH + 1 * 32>(vb);
          vlo[0][2] = tr_read<2 * 32>(vb);  vhi[0][2] = tr_read<16 * VT_PITCH + 2 * 32>(vb);
          vlo[0][3] = tr_read<3 * 32>(vb);  vhi[0][3] = tr_read<16 * VT_PITCH + 3 * 32>(vb);
          vlo[1][0] = tr_read<32 * VT_PITCH + 0 * 32>(vb);  vhi[1][0] = tr_read<48 * VT_PITCH + 0 * 32>(vb);
          vlo[1][1] = tr_read<32 * VT_PITCH + 1 * 32>(vb);  vhi[1][1] = tr_read<48 * VT_PITCH + 1 * 32>(vb);
          vlo[1][2] = tr_read<32 * VT_PITCH + 2 * 32>(vb);  vhi[1][2] = tr_read<48 * VT_PITCH + 2 * 32>(vb);
          vlo[1][3] = tr_read<32 * VT_PITCH + 3 * 32>(vb);  vhi[1][3] = tr_read<48 * VT_PITCH + 3 * 32>(vb); }
        __builtin_amdgcn_sched_barrier(0);
        bf16x8 pf[2][2];
#pragma unroll
        for (int qt = 0; qt < 2; ++qt) {
            float rsum = 0.f;
#pragma unroll
            for (int kt = 0; kt < 4; ++kt)
#pragma unroll
                for (int e = 0; e < 4; ++e) { const float p = __builtin_amdgcn_exp2f(S[kt][qt][e]); rsum += p; S[kt][qt][e] = p; }
            lrun[qt] += rsum;
#pragma unroll
            for (int kk = 0; kk < 2; ++kk) {
                u32x4 w; w.x = cvt_pk_bf16(S[2 * kk][qt][0], S[2 * kk][qt][1]); w.y = cvt_pk_bf16(S[2 * kk][qt][2], S[2 * kk][qt][3]);
                w.z = cvt_pk_bf16(S[2 * kk + 1][qt][0], S[2 * kk + 1][qt][1]); w.w = cvt_pk_bf16(S[2 * kk + 1][qt][2], S[2 * kk + 1][qt][3]);
                pf[qt][kk] = __builtin_bit_cast(bf16x8, w);
            }
        }
        asm volatile("s_waitcnt lgkmcnt(0)" ::: "memory");
        __builtin_amdgcn_sched_barrier(0);
#pragma unroll
        for (int kk = 0; kk < 2; ++kk)
#pragma unroll
            for (int dt = 0; dt < 4; ++dt) {
                u32x4 w; w.x = vlo[kk][dt].x; w.y = vlo[kk][dt].y; w.z = vhi[kk][dt].x; w.w = vhi[kk][dt].y;
                const bf16x8 af = __builtin_bit_cast(bf16x8, w);
#pragma unroll
                for (int qt = 0; qt < 2; ++qt) O[dt][qt] = __builtin_amdgcn_mfma_f32_16x16x32_bf16(af, pf[qt][kk], O[dt][qt], 0, 0, 0);
            }
        if (jt + 1 < nt) swrite((jt + 1) & 1);
        __syncthreads();
    }
#pragma unroll
    for (int qt = 0; qt < 2; ++qt) {
        float l = lrun[qt]; l += __shfl_xor(l, 16); l += __shfl_xor(l, 32);
        const float inv = 1.0f / l;
        bf16_t* op = AO + (size_t)(row0 + wave * 32 + qt * 16 + fr) * 1024 + h * 64 + fq * 4;
#pragma unroll
        for (int dt = 0; dt < 4; ++dt) { const f32x4 o = O[dt][qt] * inv; u32x2 w; w.x = pk2(o.x, o.y); w.y = pk2(o.z, o.w); *(u32x2*)(op + dt * 16) = w; }
    }
}
__device__ __forceinline__ void attn_phase(const Args& a, LAS unsigned char* lds, int bx) {
    const int G = ogrid();
    const int vcu = (G % 8 == 0) ? (bx % 8) * (G / 8) + bx / 8 : bx;
    float gmax = 0.f;
    for (int i = 0; i < 96; ++i) gmax = fmaxf(gmax, fabsf(a.in[23][i]));
    { const int tid = otid(); LAS f32x2* rtw = (LAS f32x2*)(lds + ROPE_OFF); const int pos = tid >> 3, i = tid & 7;
      const float ang = (float)pos * exp2f(-(float)i * 1.6609640474436813f); rtw[tid] = (f32x2){cosf(ang), sinf(ang)}; }
    __syncthreads();
    const float kbound = 9.797958971132712f * gmax * 1.01f;
    for (int u = vcu; u < 1536; u += G) attn_unit(a, lds, u, kbound);
}

#define FPAD(i) ((i) + ((i) >> 4))
constexpr int TW_OFF = (8192 + 512) * 8, TW_R13 = 1365, TW_R9 = 1365 + 4096, TW_N = 1365 + 4096 + 256;
__device__ __forceinline__ void build_twiddles(LAS unsigned char* lds, int tid) {
    LAS f32x2* tw = (LAS f32x2*)(lds + TW_OFF);
    for (int j = tid; j < TW_N; j += 512) {
        float ang;
        if (j < TW_R13) { int off = 0, p = 1; while (j >= off + p) { off += p; p <<= 2; } ang = -(float)(j - off) / (float)(2 * p); }
        else if (j < TW_R9) ang = -(float)(j - TW_R13) * (1.0f / 4096.0f);
        else ang = -(float)(j - TW_R9) * (1.0f / 256.0f);
        float sn, cs; sincospif(ang, &sn, &cs); tw[j] = (f32x2){cs, sn};
    }
    __syncthreads();
}
__device__ __forceinline__ void r4bf(const f32x2 a0, f32x2 a1, f32x2 a2, f32x2 a3, const f32x2 w1, f32x2& o0, f32x2& o1, f32x2& o2, f32x2& o3) {
    const f32x2 w2 = cmul(w1, w1), w3 = cmul(w2, w1);
    a1 = cmul(a1, w1); a2 = cmul(a2, w2); a3 = cmul(a3, w3);
    const f32x2 v0 = a0 + a2, v1 = a0 - a2, v2 = a1 + a3, t3 = a1 - a3; const f32x2 v3 = {t3.y, -t3.x};
    o0 = v0 + v2; o1 = v1 + v3; o2 = v0 - v2; o3 = v1 - v3;
}
template <int LOGN, bool ZP = false> __device__ __forceinline__ void fft_lds(LAS f32x2* buf, int tid) {
    constexpr int N = 1 << LOGN, T16 = N >> 4, T2 = N >> 1;
    const LAS f32x2* tw = (const LAS f32x2*)((LAS unsigned char*)buf + TW_OFF);
    int p = 1, toff = 0, ps0 = 0;
    if (ZP) {
        const int b = tid >> (LOGN - 4), i = tid & (T16 - 1), base = b << LOGN;
        f32x2 u[8];
#pragma unroll
        for (int q = 0; q < 8; ++q) u[q] = buf[FPAD(base + i + q * T16)];
        f32x2 v[4][4], o[4][4];
#pragma unroll
        for (int m = 0; m < 4; ++m) { const f32x2 a0 = u[m], a1 = u[m + 4];
            v[m][0] = a0 + a1; v[m][1] = (f32x2){a0.x + a1.y, a0.y - a1.x}; v[m][2] = a0 - a1; v[m][3] = (f32x2){a0.x - a1.y, a0.y + a1.x}; }
#pragma unroll
        for (int r = 0; r < 4; ++r) r4bf(v[0][r], v[1][r], v[2][r], v[3][r], tw[1 + r], o[r][0], o[r][1], o[r][2], o[r][3]);
        __syncthreads();
        const int jb = base + 16 * i;
#pragma unroll
        for (int r = 0; r < 4; ++r)
#pragma unroll
            for (int r2 = 0; r2 < 4; ++r2) buf[FPAD(jb + r + 4 * r2)] = o[r][r2];
        __syncthreads();
        toff = 5; p = 16; ps0 = 1;
    }
#pragma unroll 1
    for (int ps = ps0; ps < (LOGN - 1) / 4; ++ps) {
        const int b = tid >> (LOGN - 4), i = tid & (T16 - 1), base = b << LOGN, k = i & (p - 1);
        f32x2 u[16];
#pragma unroll
        for (int q = 0; q < 16; ++q) u[q] = buf[FPAD(base + i + q * T16)];
        f32x2 v[4][4], o[4][4];
        { const f32x2 w1 = tw[toff + k];
#pragma unroll
          for (int m = 0; m < 4; ++m) r4bf(u[m], u[m + 4], u[m + 8], u[m + 12], w1, v[m][0], v[m][1], v[m][2], v[m][3]); }
#pragma unroll
        for (int r = 0; r < 4; ++r) { const f32x2 w1 = tw[toff + p + k + r * p];
            r4bf(v[0][r], v[1][r], v[2][r], v[3][r], w1, o[r][0], o[r][1], o[r][2], o[r][3]); }
        __syncthreads();
        const int jb = base + 16 * (i - k) + k;
#pragma unroll
        for (int r = 0; r < 4; ++r)
#pragma unroll
            for (int r2 = 0; r2 < 4; ++r2) buf[FPAD(jb + r * p + 4 * p * r2)] = o[r][r2];
        __syncthreads();
        toff += 5 * p; p <<= 4;
    }
#pragma unroll
    for (int q = 0; q < 8; ++q) {
        const int g = tid + q * 512, b = g >> (LOGN - 1), i = g & (T2 - 1), base = b << LOGN;
        const f32x2 u0 = buf[FPAD(base + i)]; f32x2 u1 = buf[FPAD(base + i + T2)];
        u1 = cmul(u1, tw[(LOGN == 13 ? TW_R13 : TW_R9) + i]);
        buf[FPAD(base + i)] = u0 + u1; buf[FPAD(base + i + T2)] = u0 - u1;
    }
    __syncthreads();
}

template <int LOGN> __device__ __forceinline__ void filter_unit(const Args& a, LAS unsigned char* lds, int unit) {
    constexpr int N = 1 << LOGN, n = N >> 1, NB = 8192 >> LOGN;
    const int tid = otid();
    LAS f32x2* buf = (LAS f32x2*)lds; LAS f32x2* red = (LAS f32x2*)(lds + 131072); LAS f32x2* sums = red + 512;
    const int c0 = unit * 2 * NB;
    const float* HFB = (const float*)(a.ws + WS_HFB) + (n == 256 ? 0 : 256);
    const float zz = ozero();
#pragma unroll
    for (int q = 0; q < 8; ++q) {
        const int item = tid + q * 512, t = item & (n - 1), cb = item >> (LOGN - 1), ca = c0 + 2 * cb;
        const float hfa = HFB[(size_t)ca * 4352 + t], hba = HFB[(size_t)(1024 + ca) * 4352 + t];
        const float hfb = HFB[(size_t)(ca + 1) * 4352 + t], hbb = HFB[(size_t)(1024 + ca + 1) * 4352 + t];
        buf[FPAD(cb * N + t)] = (f32x2){hfa, hfb};
        if (t >= 1) buf[FPAD(cb * N + N - t)] = (f32x2){hba, hbb}; else buf[FPAD(cb * N + n)] = (f32x2){zz, zz};
    }
    __syncthreads();
    { f32x2 s = {zz, zz};
#pragma unroll
      for (int i = 0; i < 16; ++i) { const f32x2 v = buf[tid * 17 + i]; s.x += fabsf(v.x); s.y += fabsf(v.y); }
      red[tid] = s; }
    __syncthreads();
    if (tid < 64) {
        f32x2 s = {zz, zz};
#pragma unroll
        for (int i = 0; i < 8; ++i) s = s + red[tid * 8 + i];
#pragma unroll
        for (int o = 1; o < 64 / NB; o <<= 1) { s.x += __shfl_xor(s.x, o); s.y += __shfl_xor(s.y, o); }
        if ((tid & (64 / NB - 1)) == 0) sums[tid / (64 / NB)] = (f32x2){0.5f / s.x, 0.5f / s.y};
    }
    __syncthreads();
    fft_lds<LOGN>(buf, tid);
    f32x2* SP = (f32x2*)(a.ws + WS_Z + (n == 256 ? SPEC_P_OFF : 0)); const int stride = n == 256 ? SPP_STRIDE : SPS_STRIDE;
    for (int idx = tid; idx < NB * (n + 1); idx += 512) { const int cb = idx / (n + 1), k = idx - cb * (n + 1);
        const f32x2 zk = buf[FPAD(cb * N + k)], zm = buf[FPAD(cb * N + ((N - k) & (N - 1)))]; const f32x2 sc = sums[cb];
        SP[(size_t)(c0 + 2 * cb) * stride + k] = (f32x2){(zk.x + zm.x) * sc.x, (zk.y - zm.y) * sc.x};
        SP[(size_t)(c0 + 2 * cb + 1) * stride + k] = (f32x2){(zk.y + zm.y) * sc.y, (zm.x - zk.x) * sc.y}; }
    __syncthreads();
}

__device__ __forceinline__ void hfb_unit(const Args& a, LAS unsigned char* lds, int unit) {
    const int tid = otid(), w = tid >> 6, l = tid & 63;
    LAS float* As = (LAS float*)lds; LAS float* Ws = (LAS float*)(lds + 20480);
    const int tt = unit >> 4, ct = unit & 15, p0 = tt * 64, cc0 = ct * 128;
    const float* A3 = (const float*)(a.ws + WS_A3); const float* w3 = a.in[34];
    { const int t = tid >> 3, k0 = (tid & 7) * 8; const f32x4 v0 = *(const f32x4*)(A3 + (size_t)(p0 + t) * 64 + k0), v1 = *(const f32x4*)(A3 + (size_t)(p0 + t) * 64 + k0 + 4);
      LAS float* d = As + t * 65 + k0; d[0] = v0.x; d[1] = v0.y; d[2] = v0.z; d[3] = v0.w; d[4] = v1.x; d[5] = v1.y; d[6] = v1.z; d[7] = v1.w; }
#pragma unroll
    for (int q = 0; q < 4; ++q) { const int idx = tid + q * 512, k = idx >> 5, c4 = idx & 31; *(LAS f32x4*)(Ws + k * 128 + c4 * 4) = *(const f32x4*)(w3 + (size_t)k * 2048 + cc0 + c4 * 4); }
    __syncthreads();
    f32x4 acc[4];
#pragma unroll
    for (int q = 0; q < 4; ++q) acc[q] = (f32x4){0.f, 0.f, 0.f, 0.f};
#pragma unroll 8
    for (int k = 0; k < 64; ++k) { const float av = As[l * 65 + k];
#pragma unroll
        for (int q = 0; q < 4; ++q) acc[q] = acc[q] + *(const LAS f32x4*)(Ws + k * 128 + w * 16 + 4 * q) * av; }
    const int pos = p0 + l, n = pos < 256 ? 256 : 4096, t = pos < 256 ? pos : pos - 256;
    const float t01 = (float)t / (float)(n - 1);
    const float dlo = -3.0701134573253946f, dhi = -15.350567286626973f;
    float* HFB = (float*)(a.ws + WS_HFB);
#pragma unroll
    for (int q = 0; q < 4; ++q)
#pragma unroll
        for (int e = 0; e < 4; ++e) { const int cc = cc0 + w * 16 + 4 * q + e; const float delta = fabsf(dlo + (dhi - dlo) * (float)(cc & 1023) / 1023.0f);
            HFB[(size_t)cc * 4352 + pos] = acc[q][e] * expf(-t01 * delta); }
    __syncthreads();
}

template <int LOGN> __device__ __forceinline__ void conv_unit(const Args& a, LAS unsigned char* lds, int c, int pr) {
    constexpr int N = 1 << LOGN, n = N >> 1, NB = 8192 >> LOGN, CPS = n / 8;
    const int tid = otid();
    LAS f32x2* buf = (LAS f32x2*)lds; LAS float* bufF = (LAS float*)lds;
    const float zz = ozero();
    bf16_t* VXT = (bf16_t*)(a.ws + WS_XS) + (n == 256 ? 0 : (size_t)32 * 1024 * 256);
#pragma unroll
    for (int q = 0; q < 2; ++q) {
        const int chunk = tid + q * 512, sq = chunk / CPS, ck = chunk - sq * CPS, pair = sq >> 1, part = sq & 1;
        const int bsel = (n == 256) ? (2 * pair + part) : (2 * pr + part);
        float f[8]; unpack8(*(const u32x4*)(VXT + ((size_t)bsel * 1024 + c) * n + ck * 8), f);
#pragma unroll
        for (int i = 0; i < 8; ++i) bufF[FPAD(pair * N + ck * 8 + i) * 2 + part] = f[i];
    }
    __syncthreads();
    fft_lds<LOGN, true>(buf, tid);
    const f32x2* SP = (const f32x2*)(a.ws + WS_Z + (n == 256 ? SPEC_P_OFF : 0)) + (size_t)c * (n == 256 ? SPP_STRIDE : SPS_STRIDE);
    { f32x2 F[16];
#pragma unroll
      for (int q = 0; q < 16; ++q) { const int k = (tid + q * 512) & (N - 1); F[q] = SP[k <= n ? k : N - k]; }
#pragma unroll
      for (int q = 0; q < 16; ++q) { const int idx = tid + q * 512, k = idx & (N - 1);
          f32x2 Fq = F[q]; if (k > n) Fq.y = -Fq.y;
          const f32x2 w = cmul(buf[FPAD(idx)], Fq); buf[FPAD(idx)] = (f32x2){w.x, -w.y}; } }
    __syncthreads();
    fft_lds<LOGN>(buf, tid);
    const float sc = 1.0f / (float)N;
#pragma unroll
    for (int q = 0; q < 2; ++q) {
        const int chunk = tid + q * 512, sq = chunk / CPS, ck = chunk - sq * CPS, pair = sq >> 1, part = sq & 1;
        const int bsel = (n == 256) ? (2 * pair + part) : (2 * pr + part);
        float f[8];
#pragma unroll
        for (int i = 0; i < 8; ++i) { const float v = bufF[FPAD(pair * N + ck * 8 + i) * 2 + part]; f[i] = part ? -v * sc : v * sc; }
        *(u32x4*)(VXT + ((size_t)bsel * 1024 + c) * n + ck * 8) = pack8(f);
    }
    __syncthreads();
}

__device__ __forceinline__ void hy_load6(const bf16_t* U3, int row0, int col, int t0, int L, u32x4 (&raw)[6]) {
#pragma unroll
    for (int r = 0; r < 6; ++r) { const int t = t0 + r - 1; raw[r] = (t >= 0 && t < L) ? *(const u32x4*)(U3 + (size_t)(row0 + r - 1) * 3072 + col) : (u32x4){0u, 0u, 0u, 0u}; }
}
__device__ __forceinline__ void hy_conv4x8(const u32x4 (&raw)[6], int col, const float* cw, const float* cb, float (&o)[4][8]) {
    float w0[8], w1[8], w2[8], bb[8];
    { const f32x4 a0 = *(const f32x4*)(cw + col), a1 = *(const f32x4*)(cw + col + 4), b0 = *(const f32x4*)(cw + 3072 + col), b1 = *(const f32x4*)(cw + 3072 + col + 4),
                  d0 = *(const f32x4*)(cw + 6144 + col), d1 = *(const f32x4*)(cw + 6144 + col + 4), e0 = *(const f32x4*)(cb + col), e1 = *(const f32x4*)(cb + col + 4);
#pragma unroll
      for (int i = 0; i < 4; ++i) { w0[i] = a0[i]; w0[4 + i] = a1[i]; w1[i] = b0[i]; w1[4 + i] = b1[i]; w2[i] = d0[i]; w2[4 + i] = d1[i]; bb[i] = e0[i]; bb[4 + i] = e1[i]; } }
    float win[6][8];
#pragma unroll
    for (int r = 0; r < 6; ++r) unpack8(raw[r], win[r]);
#pragma unroll
    for (int r = 0; r < 4; ++r)
#pragma unroll
        for (int i = 0; i < 8; ++i) o[r][i] = w0[i] * win[r][i] + w1[i] * win[r + 1][i] + w2[i] * win[r + 2][i] + bb[i];
}
#define HT_SW(c, q) ((c) * HT_P + ((((q) + ((c) >> 3)) & 31) << 2))
constexpr int HT_P = 132;
template <int MODE> __device__ __forceinline__ void hy_tile_phase(const Args& a, LAS unsigned char* lds) {
    const int tid = otid(), G = ogrid();
    const bf16_t* U3 = (const bf16_t*)(a.ws + WS_AR); bf16_t* VX = (bf16_t*)(a.ws + WS_XS); bf16_t* Z = (bf16_t*)(a.ws + WS_Z);
    const float* cw = a.in[26]; const float* cb = a.in[27]; const float* hb = a.in[36];
    LAS float* T = (LAS float*)lds;
    const int cgp = tid & 15, strip = tid >> 4;
    for (int u = obid(); u < (M / 128) * 8; u += G) {
        const int rt = u >> 3, ct = u & 7, row0 = rt * 128, c0 = ct * 128;
        const bool pr = row0 < MP; const int L = pr ? 256 : 4096, b = pr ? (row0 >> 8) : ((row0 - MP) >> 12), t0 = pr ? (row0 & 255) : ((row0 - MP) & 4095);
        bf16_t* seq = VX + (pr ? 0 : (size_t)32 * 1024 * 256) + ((size_t)b * 1024 + c0) * L + t0;
        const int c = c0 + cgp * 8, r0 = strip * 4, row = row0 + r0, t = t0 + r0;
        u32x4 raw1[6], raw2[6];
        hy_load6(U3, row, 1024 + c, t, L, raw1); hy_load6(U3, row, 2048 + c, t, L, raw2);
        if (MODE == 1) {
            u32x4 yr[4];
#pragma unroll
            for (int q = 0; q < 4; ++q) { const int it = tid + q * 512, c = it >> 4, ck = it & 15; yr[q] = *(const u32x4*)(seq + (size_t)c * L + ck * 8); }
#pragma unroll
            for (int q = 0; q < 4; ++q) { const int it = tid + q * 512, c = it >> 4, ck = it & 15; float f[8]; unpack8(yr[q], f);
                *(LAS f32x4*)(T + HT_SW(c, 2 * ck)) = (f32x4){f[0], f[1], f[2], f[3]}; *(LAS f32x4*)(T + HT_SW(c, 2 * ck + 1)) = (f32x4){f[4], f[5], f[6], f[7]}; }
            __syncthreads();
        }
        {
            float x1[4][8], v[4][8];
            hy_conv4x8(raw1, 1024 + c, cw, cb, x1); hy_conv4x8(raw2, 2048 + c, cw, cb, v);
            if (MODE == 0) {
#pragma unroll
                for (int i = 0; i < 8; ++i) *(LAS f32x4*)(T + HT_SW(cgp * 8 + i, strip)) = (f32x4){v[0][i] * x1[0][i], v[1][i] * x1[1][i], v[2][i] * x1[2][i], v[3][i] * x1[3][i]};
            } else {
                u32x4 raw0[6]; hy_load6(U3, row, c, t, L, raw0);
                float x0[4][8], hbv[8]; hy_conv4x8(raw0, c, cw, cb, x0);
                { const f32x4 h0 = *(const f32x4*)(hb + c), h1 = *(const f32x4*)(hb + c + 4);
#pragma unroll
                  for (int i = 0; i < 4; ++i) { hbv[i] = h0[i]; hbv[4 + i] = h1[i]; } }
                f32x4 yv[8];
#pragma unroll
                for (int i = 0; i < 8; ++i) yv[i] = *(const LAS f32x4*)(T + HT_SW(cgp * 8 + i, strip));
#pragma unroll
                for (int r = 0; r < 4; ++r) { float o[8];
#pragma unroll
                    for (int i = 0; i < 8; ++i) o[i] = (yv[i][r] + v[r][i] * x1[r][i] * hbv[i]) * x0[r][i];
                    *(u32x4*)(Z + (size_t)(row + r) * 1024 + c) = pack8(o); }
            }
        }
        __syncthreads();
        if (MODE == 0) {
#pragma unroll
            for (int q = 0; q < 4; ++q) { const int it = tid + q * 512, c = it >> 4, ck = it & 15;
                const f32x4 a0 = *(const LAS f32x4*)(T + HT_SW(c, 2 * ck)), a1 = *(const LAS f32x4*)(T + HT_SW(c, 2 * ck + 1));
                float f[8] = {a0.x, a0.y, a0.z, a0.w, a1.x, a1.y, a1.z, a1.w};
                *(u32x4*)(seq + (size_t)c * L + ck * 8) = pack8(f); }
            __syncthreads();
        }
    }
}

#define XB_XCNT(j)  (256  + 64 * (j))
#define XB_XSUB(j)  (1280 + 64 * (j))
#define XB_XGEN(j)  (2304 + 64 * (j))
#define XB_TOP      3328
#define XB_TOPGEN   3392
#define XB_WORDS    3456
__device__ __forceinline__ unsigned xb_ld(unsigned* p) { return __hip_atomic_load(p, __ATOMIC_RELAXED, __HIP_MEMORY_SCOPE_AGENT); }
__device__ __forceinline__ unsigned xb_add(unsigned* p, unsigned v) { return __hip_atomic_fetch_add(p, v, __ATOMIC_RELAXED, __HIP_MEMORY_SCOPE_AGENT); }
__device__ __forceinline__ unsigned xb_xcc_id() { return (unsigned)__builtin_amdgcn_s_getreg((3 << 11) | 20) & 0xFu; }
#define XB_SPIN(cond) do { unsigned _sp = 0; while (cond) { __builtin_amdgcn_s_sleep(1); if (++_sp > (1u << 24)) break; } } while (0)
__device__ __forceinline__ void gbar(unsigned* bar, unsigned x, volatile LAS unsigned* cw) {
    asm volatile("s_waitcnt vmcnt(0) lgkmcnt(0)" ::: "memory");
    __syncthreads();
    if (threadIdx.x == 0) {
        const unsigned nloc = cw[0], nx = cw[1];
        const unsigned old = xb_add(&bar[XB_XSUB(x)], 1u);
        const unsigned gen = old / nloc;
        if (old + 1u == (gen + 1u) * nloc) {
            __builtin_amdgcn_fence(__ATOMIC_RELEASE, "agent");
            asm volatile("s_waitcnt vmcnt(0)" ::: "memory");
            const unsigned og = xb_add(&bar[XB_TOP], 1u);
            const unsigned tg = og / nx;
            if (og + 1u == (tg + 1u) * nx) xb_add(&bar[XB_TOPGEN], 1u);
            else XB_SPIN(xb_ld(&bar[XB_TOPGEN]) == tg);
            __builtin_amdgcn_fence(__ATOMIC_ACQUIRE, "agent");
            xb_add(&bar[XB_XGEN(x)], 1u);
            asm volatile("s_waitcnt vmcnt(0)" ::: "memory");
        } else {
            XB_SPIN(xb_ld(&bar[XB_XGEN(x)]) == gen);
            __builtin_amdgcn_fence(__ATOMIC_ACQUIRE, "agent");
            asm volatile("s_waitcnt vmcnt(0)" ::: "memory");
        }
    }
    __syncthreads();
}

struct GP { const bf16_t* A; const bf16_t* Bt; int M_, N_, K_; int kind;
            void* O; int ldc; const float* bias; int nb; int act, f32out, norm, remap;
            const float* g; const float* gsn; };

__global__ void __launch_bounds__(512, 2) fwd(Args a) {
    extern __shared__ __attribute__((aligned(16))) unsigned char lds_raw[];
    LAS unsigned char* lds = (LAS unsigned char*)lds_raw;
    cg::grid_group grid = cg::this_grid();
    unsigned char* ws = a.ws;
    unsigned* bar = (unsigned*)(ws + WS_BAR);
    const unsigned myx = xb_xcc_id();
    volatile LAS unsigned* cw = (volatile LAS unsigned*)(lds + LDS_BYTES - 32);
    if (threadIdx.x == 0) *(volatile LAS unsigned*)(lds + LDS_BYTES - 16) = xb_add(&bar[XB_XCNT(myx)], 1u);
    __syncthreads();
    const unsigned myrank = (unsigned)__builtin_amdgcn_readfirstlane((int)*(volatile LAS unsigned*)(lds + LDS_BYTES - 16));
    int vbid = (int)blockIdx.x;
    const float* MODV = (const float*)(ws + WS_MODV); const float* GS = (const float*)(ws + WS_GS); const float* BIAS = (const float*)(ws + WS_BIAS);
    float* SSQ = (float*)(ws + WS_SSQ);
    bf16_t* XS = (bf16_t*)(ws + WS_XS); bf16_t* Zb = (bf16_t*)(ws + WS_Z); bf16_t* AR = (bf16_t*)(ws + WS_AR);
    const bf16_t* W1 = (const bf16_t*)(ws + WS_MLP1); const bf16_t* W2 = (const bf16_t*)(ws + WS_MLP2);
#define WPTR(off) ((const bf16_t*)(ws + WS_W + (off)))
    for (int ph = a.ph_lo; ph < a.ph_hi; ++ph) {
      if (ph == 10) continue;
      const int G = ogrid();
      const int ndup = 1 + (int)((DUP_MASK >> ph) & 1u);
      for (int dup = 0; dup < ndup; ++dup) {
        int nrep = 0;
        GP p; p.A = nullptr; p.Bt = nullptr; p.M_ = M; p.N_ = 0; p.K_ = 1024; p.kind = 0; p.O = nullptr; p.ldc = 0; p.bias = nullptr; p.nb = 0; p.act = 0; p.f32out = 0; p.norm = 0; p.remap = 0; p.g = nullptr; p.gsn = nullptr;
        switch (ph) {
            case 0: phase0(a, lds); break;
            case 1: phase1(a, lds); break;
            case 3: sc_conv_phase(a, 0); break;
            case 23: sc_conv_phase(a, 1); break;
            case 8: mla_latent_phase(a); break;
            case 10: kq_finalize_phase(a, lds); break;
            case 11: attn_phase(a, lds, vbid); break;
            case 16: {
                hy_tile_phase<0>(a, lds);
            } break;
            case 17: {
                const int bx = obid();
                build_twiddles(lds, otid());
                for (int u = bx; u < 3072; u += G) { if (u < 2048) conv_unit<13>(a, lds, u >> 1, u & 1); else conv_unit<9>(a, lds, u - 2048, 0); }
            } break;
            case 18: hy_tile_phase<1>(a, lds); break;
            case 2: case 22: nrep = 1; p.kind = 1; p.A = XS; p.Bt = WPTR(ph == 2 ? OFF_SCIN0 : OFF_SCIN1); p.N_ = 3072; p.O = AR; p.ldc = 3072; p.bias = BIAS + (ph == 2 ? B_IN0 : B_IN3); p.nb = 3072; p.norm = 1; break;
            case 15: nrep = 1; p.kind = 1; p.A = XS; p.Bt = WPTR(OFF_HYIN); p.N_ = 3072; p.O = AR; p.ldc = 3072; p.bias = BIAS + B_HY; p.nb = 3072; p.norm = 1; break;
            case 5: case 13: case 20: case 25: { const int l = ph == 5 ? 0 : ph == 13 ? 1 : ph == 20 ? 2 : 3;
                nrep = 1; p.kind = 1; p.A = XS; p.Bt = W1; p.N_ = 4096; p.O = AR; p.ldc = 4096; p.bias = BIAS + (l == 0 ? B_M0 : l == 1 ? B_M1 : l == 2 ? B_M2 : B_M3); p.nb = 4096; p.norm = 1; p.act = 1; } break;
            case 7: nrep = 1; p.kind = 1; p.A = XS; p.Bt = WPTR(OFF_DQKV); p.N_ = 768; p.O = (void*)(ws + WS_AR + AR_QKVL); p.ldc = 768; p.bias = BIAS + B_DQKV; p.nb = 768; p.norm = 1; p.f32out = 1; break;
            case 9: nrep = 2; break;
            case 4: case 24: { const int l = ph == 4 ? 0 : 3; nrep = 1; p.kind = 2; p.A = Zb; p.Bt = WPTR(ph == 4 ? OFF_SCOUT0 : OFF_SCOUT1); p.N_ = 1024; p.g = MODV + (size_t)l * 5 * 6144 + 2 * 1024; p.gsn = GS + (size_t)(l * 2 + 1) * 5120; } break;
            case 12: nrep = 1; p.kind = 2; p.A = (const bf16_t*)(ws + WS_AR + AR_AO); p.Bt = WPTR(OFF_WO); p.N_ = 1024; p.g = MODV + (size_t)1 * 5 * 6144 + 2 * 1024; p.gsn = GS + (size_t)(1 * 2 + 1) * 5120; break;
            case 19: nrep = 1; p.kind = 2; p.A = Zb; p.Bt = WPTR(OFF_HYOUT); p.N_ = 1024; p.g = MODV + (size_t)2 * 5 * 6144 + 2 * 1024; p.gsn = GS + (size_t)(2 * 2 + 1) * 5120; break;
            case 6: case 14: case 21: case 26: { const int l = ph == 6 ? 0 : ph == 14 ? 1 : ph == 21 ? 2 : 3;
                nrep = 1; p.kind = 2; p.A = AR; p.Bt = W2; p.N_ = 1024; p.K_ = 4096; p.g = MODV + (size_t)l * 5 * 6144 + 5 * 1024; p.gsn = l < 3 ? GS + (size_t)((l + 1) * 2) * 5120 : nullptr; } break;
            default: break;
        }
        for (int rep = 0; rep < nrep; ++rep) {
            if (ph == 9) {
                p.kind = 1; p.norm = 0; p.bias = nullptr; p.act = 0; p.f32out = 0;
                if (rep == 0) { p.A = (const bf16_t*)(ws + WS_AR + AR_CQ); p.Bt = WPTR(OFF_WUQ); p.M_ = M; p.N_ = 1536; p.K_ = 384; p.O = (void*)XS; p.ldc = 1536; p.remap = 0; }
                else { p.A = (const bf16_t*)(ws + WS_AR + AR_CKV); p.Bt = WPTR(OFF_WUKV); p.M_ = MKV; p.N_ = 2048; p.K_ = 256; p.O = (void*)(ws + WS_AR + AR_KV); p.ldc = 2560; p.remap = 1; }
            }
            pg8::Gemm g{p.A, p.Bt, p.M_, p.N_, p.K_}; pg8::StaticOrder S; S.init(p.M_, p.N_, G, vbid);
            if (p.kind == 1) { pg8::EpiA E{p.O, p.ldc, p.bias, p.nb, SSQ, p.act, p.f32out, p.norm, p.remap}; pg8::gemm_phase<pg8::EpiA>(lds, g, S, E);
                               if (ph == 9 && rep == 1) k_finalize_own_units(a, lds, S);
                               if (ph == 7 && vbid >= 32) do_transposes(a, lds, 11, 13, 1, vbid - 32, G - 32);
                               if (ph == 22 && vbid >= G / 2) do_transposes(a, lds, 11, 13, 3, vbid - G / 2, G - G / 2); }
            else { pg8::EpiB E{a.out, p.g, p.gsn, XS, SSQ, ph == 4 ? a.in[0] : nullptr, ph == 4 ? a.in[1] : nullptr}; pg8::gemm_phase<pg8::EpiB>(lds, g, S, E);
                   if (ph == 19 && vbid >= G / 2) do_transposes(a, lds, 11, 13, 2, vbid - G / 2, G - G / 2);
                   if (ph == 14 && vbid >= G / 2) { build_twiddles(lds, otid());
                       for (int u = vbid - G / 2; u < 512 + 32; u += G / 2) { if (u < 512) filter_unit<13>(a, lds, u); else filter_unit<9>(a, lds, u - 512); } } }
        }
      }
        if (ph + 1 < a.ph_hi) {
            if (ph == 0) {
                grid.sync();
                unsigned mine = 0u, cnt = 0u;
#pragma unroll
                for (unsigned j = 0; j < 16; ++j) { const unsigned c = xb_ld(&bar[XB_XCNT(j)]); cnt += (c > 0u) ? 1u : 0u; mine = (j == myx) ? c : mine; }
                if (threadIdx.x == 0) { cw[0] = mine > 0u ? mine : 1u; cw[1] = cnt > 0u ? cnt : 1u; }
                { bool uni = (gridDim.x % 8u) == 0u;
#pragma unroll
                  for (unsigned j = 0; j < 16; ++j) { const unsigned c = xb_ld(&bar[XB_XCNT(j)]); uni = uni && (c == (j < 8u ? gridDim.x / 8u : 0u)); }
                  if (uni) vbid = (int)(myrank * 8u + myx); }
            } else gbar(bar, myx, cw);
            for (int e = 0; e < EXTRA_SYNCS; ++e) grid.sync();
        }
    }
#undef WPTR
}

extern "C" void kernel_launch(void* const* d_in, const int* in_sizes, int n_in, void* d_out, int out_size, void* d_ws, size_t ws_size, hipStream_t stream) {
    static int grid = 0;
    if (grid == 0) {
        if (n_in != 38 || ws_size < WS_END) { fprintf(stderr, "kernel_launch: unexpected n_in %d / ws_size %zu (need %zu)\n", n_in, ws_size, (size_t)WS_END); grid = -1; return; }
        int dev = 0, cus = 0, per_cu = 0;
        (void)hipGetDevice(&dev); (void)hipDeviceGetAttribute(&cus, hipDeviceAttributeMultiprocessorCount, dev);
        (void)hipFuncSetAttribute((const void*)fwd, hipFuncAttributeMaxDynamicSharedMemorySize, LDS_BYTES);
        if (hipOccupancyMaxActiveBlocksPerMultiprocessor(&per_cu, (const void*)fwd, 512, LDS_BYTES) != hipSuccess || per_cu < 1) per_cu = 1;
        (void)hipGetLastError();
        grid = cus * per_cu;
        if (grid <= 0) grid = 256;
    }
    if (grid < 0) return;
    (void)hipMemsetAsync((unsigned char*)d_ws + WS_BAR, 0, XB_WORDS * 4, stream);
    Args a{};
    for (int i = 0; i < 38; ++i) a.in[i] = (const float*)d_in[i];
    a.out = (float*)d_out; a.ws = (unsigned char*)d_ws;
#if ONE_LAUNCH
    a.ph_lo = 0; a.ph_hi = NPH;
    void* args[] = {&a};
    hipError_t e = hipLaunchCooperativeKernel((const void*)fwd, dim3(grid), dim3(512), args, LDS_BYTES, stream);
    if (e != hipSuccess) fprintf(stderr, "cooperative launch failed: %s (grid %d)\n", hipGetErrorString(e), grid);
#else
    for (int ph = 0; ph < NPH; ++ph) { a.ph_lo = ph; a.ph_hi = ph + 1; hipLaunchKernelGGL(fwd, dim3(grid), dim3(512), LDS_BYTES, stream, a); }
#endif
}
```

```cpp
#include <hip/hip_runtime.h>
#include <hip/hip_cooperative_groups.h>
#include <cstdio>
#include <cstdint>
namespace cg = cooperative_groups;

#ifndef ONE_LAUNCH
#define ONE_LAUNCH 1
#endif

#ifndef DUP_MASK
#define DUP_MASK 0u
#endif
#ifndef EXTRA_SYNCS
#define EXTRA_SYNCS 0
#endif
#define LAS __attribute__((address_space(3)))
typedef unsigned short bf16_t;
typedef short bf16x8 __attribute__((ext_vector_type(8)));
typedef float f32x4 __attribute__((ext_vector_type(4)));
typedef float f32x2 __attribute__((ext_vector_type(2)));
typedef unsigned u32x4 __attribute__((ext_vector_type(4)));
typedef unsigned u32x2 __attribute__((ext_vector_type(2)));

constexpr int D = 1024, MP = 8192, MS = 16384, M = 24576, NCACHE = 2048, MKV = M + NCACHE, FF = 4096;
constexpr int NPH = 27;
constexpr float EPS = 1e-6f;
constexpr int LDS_BYTES = 147456;
constexpr size_t MiB = 1u << 20;
constexpr size_t WS_MODV = 0;
constexpr size_t WS_GS = 512 * 1024;
constexpr size_t WS_BIAS = 768 * 1024;
constexpr size_t WS_SSQ = 2 * MiB;
constexpr size_t WS_A3 = 4 * MiB;
constexpr size_t WS_BAR = 7 * MiB;
constexpr size_t WS_W = 8 * MiB;
constexpr size_t OFF_SCIN0 = 0, OFF_SCOUT0 = 6 * MiB, OFF_SCIN1 = 8 * MiB, OFF_SCOUT1 = 14 * MiB, OFF_HYIN = 16 * MiB, OFF_HYOUT = 22 * MiB,
                 OFF_WO = 24 * MiB, OFF_DQKV = 26 * MiB, OFF_WUQ = 28 * MiB, OFF_WUKV = 30 * MiB;
constexpr size_t WS_MLP1 = 40 * MiB, WS_MLP2 = 48 * MiB;
constexpr size_t WS_XS = 56 * MiB;
constexpr size_t WS_Z = 104 * MiB;
constexpr size_t WS_AR = 152 * MiB;
constexpr size_t WS_HFB = 344 * MiB;
constexpr size_t WS_END = 380 * MiB;
constexpr size_t AR_KV = 0, AR_QKVL = 0, AR_CQ = 130 * MiB, AR_CKV = 148 * MiB, AR_KPE = 161 * MiB, AR_AO = 130 * MiB;
constexpr int B_IN0 = 0, B_M0 = 15360, B_DQKV = 35840, B_M1 = 39680, B_HY = 60160, B_M2 = 75520, B_IN3 = 96000, B_M3 = 111360;
constexpr int SPS_STRIDE = 4104, SPP_STRIDE = 264;
constexpr size_t SPEC_P_OFF = (size_t)1024 * SPS_STRIDE * 8;
constexpr size_t OUT_CKV = (size_t)M * D, OUT_KPE = OUT_CKV + (size_t)MP * 256;

struct Args { const float* in[38]; float* out; unsigned char* ws; int ph_lo, ph_hi; };

__device__ __forceinline__ unsigned f2bf(float f) { unsigned u = __float_as_uint(f); return (u + 0x7fffu + ((u >> 16) & 1u)) >> 16; }
__device__ __forceinline__ unsigned pk2(float lo, float hi) { return f2bf(lo) | (f2bf(hi) << 16); }
__device__ __forceinline__ float bflo(unsigned w) { return __uint_as_float(w << 16); }
__device__ __forceinline__ float bfhi(unsigned w) { return __uint_as_float(w & 0xffff0000u); }
__device__ __forceinline__ unsigned cvt_pk_bf16(float lo, float hi) { unsigned r; asm volatile("v_cvt_pk_bf16_f32 %0, %1, %2" : "=v"(r) : "v"(lo), "v"(hi)); return r; }
__device__ __forceinline__ float wave_sum(float v) {
#pragma unroll
    for (int o = 1; o < 64; o <<= 1) v += __shfl_xor(v, o);
    return v;
}
__device__ __forceinline__ void unpack8(const u32x4 w, float (&f)[8]) {
    f[0] = bflo(w.x); f[1] = bfhi(w.x); f[2] = bflo(w.y); f[3] = bfhi(w.y); f[4] = bflo(w.z); f[5] = bfhi(w.z); f[6] = bflo(w.w); f[7] = bfhi(w.w);
}
__device__ __forceinline__ u32x4 pack8(const float (&f)[8]) {
    u32x4 w; w.x = pk2(f[0], f[1]); w.y = pk2(f[2], f[3]); w.z = pk2(f[4], f[5]); w.w = pk2(f[6], f[7]); return w;
}
__device__ __forceinline__ int otid() { int t = threadIdx.x; asm volatile("" : "+v"(t)); return t; }
__device__ __forceinline__ float ozero() { float z = 0.f; asm volatile("" : "+v"(z)); return z; }
__device__ __forceinline__ int ogrid() { int g = gridDim.x; asm volatile("" : "+s"(g)); return g; }
__device__ __forceinline__ int obid() { int b = blockIdx.x; asm volatile("" : "+s"(b)); return b; }
__device__ __forceinline__ f32x2 cmul(f32x2 a, f32x2 b) { f32x2 r; r.x = a.x * b.x - a.y * b.y; r.y = a.x * b.y + a.y * b.x; return r; }

namespace pg8 {
constexpr int BM = 256, BK = 64, HALF = 128, HTB = HALF * BK * 2, STAGE_BYTES = 8 * HTB, NXCD = 8, WGM = 8;
__device__ __forceinline__ int lds_byte(int r, int c) { const int st = (r >> 4) * 2 + (c >> 5), rr = r & 15, cc = c & 31, ob = rr * 64 + cc * 2; return st * 1024 + (ob ^ (((ob >> 9) & 1) << 5)); }
__device__ __forceinline__ void stage_rc(int b, int& R, int& C) { const int st = b / 1024, sb = b % 1024, swz = sb ^ (((sb >> 9) & 1) << 5); R = (st >> 1) * 16 + swz / 64; C = (st & 1) * 32 + (swz % 64) / 2; }
__device__ __forceinline__ int perm32(int rho) { const int n = rho >> 4, i = rho & 15; return 8 * (i >> 2) + 4 * n + (i & 3); }
struct Unit { int pm, pn; };
struct Gemm { const bf16_t* A; const bf16_t* Bt; int M, N, K; };
struct StaticOrder {
    int nM, nN, nwg, G, c;
    __device__ void init(int M_, int N_, int G_, int c_) { nM = M_ / BM; nN = N_ / BM; nwg = nM * nN; G = G_; c = c_; }
    __device__ bool next(int i, Unit& u) const {
        const long L = (long)i * G + c; if (L >= nwg) return false;
        int wgid = (int)L; { const int q = nwg / NXCD, r = nwg % NXCD, xcd = wgid % NXCD, off = wgid / NXCD; wgid = (xcd < r ? xcd * (q + 1) : r * (q + 1) + (xcd - r) * q) + off; }
        const int nig = WGM * nN, gid = wgid / nig, fm = gid * WGM, gsz = (nM - fm) < WGM ? (nM - fm) : WGM;
        u.pm = fm + ((wgid % nig) % gsz); u.pn = (wgid % nig) / gsz; return true;
    }
};

struct EpiA {
    void* O; int ldc; const float* bias; int nb; const float* ssq; int act, f32out, norm, remap;
    __device__ __forceinline__ void operator()(const f32x4 (&acc)[2][2][4][2], const Unit& u, int wr, int wc, int fr, int fq) const {
        const int ci = u.pm < 32 ? 0 : 1 + ((u.pm - 32) >> 4);
        const int colb = u.pn * BM + wc * 32 + 8 * fq;
        f32x4 bv[2][2];
#pragma unroll
        for (int bj = 0; bj < 2; ++bj)
#pragma unroll
            for (int n = 0; n < 2; ++n) bv[bj][n] = bias ? *(const f32x4*)(bias + (size_t)ci * nb + colb + bj * HALF + 4 * n) : (f32x4){0.f, 0.f, 0.f, 0.f};
        float rsv0 = 1.f, rsv1 = 1.f;
        if (norm) {
            const f32x4* sp0 = (const f32x4*)(ssq + (size_t)(u.pm * BM + wr * 64 + fq * 16 + fr) * 16); const f32x4* sp1 = sp0 + (size_t)HALF * 4;
            const f32x4 a0 = sp0[0], a1 = sp0[1], a2 = sp0[2], a3 = sp0[3], b0 = sp1[0], b1 = sp1[1], b2 = sp1[2], b3 = sp1[3];
            const f32x4 s0 = (a0 + a1) + (a2 + a3), s1 = (b0 + b1) + (b2 + b3);
            rsv0 = rsqrtf(((s0.x + s0.y) + (s0.z + s0.w)) * (1.0f / 1024.0f) + EPS); rsv1 = rsqrtf(((s1.x + s1.y) + (s1.z + s1.w)) * (1.0f / 1024.0f) + EPS);
        }
        float rs8[2][4];
#pragma unroll
        for (int ai = 0; ai < 2; ++ai)
#pragma unroll
            for (int m = 0; m < 4; ++m) rs8[ai][m] = __shfl(ai ? rsv1 : rsv0, m * 16 + fr);
#pragma unroll
        for (int ai = 0; ai < 2; ++ai)
#pragma unroll
            for (int m = 0; m < 4; ++m) {
                const int row = u.pm * BM + ai * HALF + wr * 64 + m * 16 + fr;
                const float rs = rs8[ai][m];
#pragma unroll
                for (int bj = 0; bj < 2; ++bj) {
                    f32x4 v0 = acc[ai][bj][m][0] * rs + bv[bj][0], v1 = acc[ai][bj][m][1] * rs + bv[bj][1];
                    if (act) {
#pragma unroll
                        for (int e = 0; e < 4; ++e) { const float a0 = fmaxf(v0[e], 0.f), a1 = fmaxf(v1[e], 0.f); v0[e] = a0 * a0; v1[e] = a1 * a1; }
                    }
                    const int c = colb + bj * HALF; const int dc = remap ? (c >> 7) * 160 + (c & 127) : c;
                    if (f32out) { float* p = (float*)O + (size_t)row * ldc + dc; *(f32x4*)p = v0; *(f32x4*)(p + 4) = v1; }
                    else { bf16_t* p = (bf16_t*)O + (size_t)row * ldc + dc; u32x4 w; w.x = cvt_pk_bf16(v0[0], v0[1]); w.y = cvt_pk_bf16(v0[2], v0[3]); w.z = cvt_pk_bf16(v1[0], v1[1]); w.w = cvt_pk_bf16(v1[2], v1[3]); *(u32x4*)p = w; }
                }
            }
    }
};
struct EpiB {
    float* x; const float* g; const float* gsn; bf16_t* xs; float* ssq; const float* xin_p; const float* xin_s;
    __device__ __forceinline__ void operator()(const f32x4 (&acc)[2][2][4][2], const Unit& u, int wr, int wc, int fr, int fq) const {
        const int ci = u.pm < 32 ? 0 : 1 + ((u.pm - 32) >> 4);
        const int colb = u.pn * BM + wc * 32 + 8 * fq;
        f32x4 gv[2][2], sv[2][2];
#pragma unroll
        for (int bj = 0; bj < 2; ++bj)
#pragma unroll
            for (int n = 0; n < 2; ++n) {
                gv[bj][n] = *(const f32x4*)(g + (size_t)ci * 6144 + colb + bj * HALF + 4 * n);
                sv[bj][n] = gsn ? *(const f32x4*)(gsn + (size_t)ci * 1024 + colb + bj * HALF + 4 * n) : (f32x4){0.f, 0.f, 0.f, 0.f};
            }
        const float* xb0 = (xin_p ? (u.pm < 32 ? xin_p : xin_s - (size_t)MP * 1024) : (const float*)x) + (size_t)(u.pm * BM + wr * 64 + fr) * 1024 + colb;
        auto xsrc = [&](int st) -> const float* { const int i = st >> 1; return xb0 + (size_t)((i >> 2) * HALF + (i & 3) * 16) * 1024 + (st & 1) * HALF; };
        f32x4 nxa, nxb;
        { const float* xr = xsrc(0); nxa = *(const f32x4*)xr; nxb = *(const f32x4*)(xr + 4); }
        float ss = 0.f;
#pragma unroll
        for (int st = 0; st < 16; ++st) {
                const int i = st >> 1, bj = st & 1, ai = i >> 2, m = i & 3;
                const int row = u.pm * BM + ai * HALF + wr * 64 + m * 16 + fr;
                float* xp = x + (size_t)row * 1024 + colb;
                f32x4 xa = nxa, xb = nxb;
                if (st < 15) { const float* xr = xsrc(st + 1); nxa = *(const f32x4*)xr; nxb = *(const f32x4*)(xr + 4); }
                if (bj == 0) ss = 0.f;
                {
                    xa = xa + gv[bj][0] * acc[ai][bj][m][0]; xb = xb + gv[bj][1] * acc[ai][bj][m][1];
                    *(f32x4*)(xp + bj * HALF) = xa; *(f32x4*)(xp + bj * HALF + 4) = xb;
                    ss += (xa.x * xa.x + xa.y * xa.y) + (xa.z * xa.z + xa.w * xa.w) + (xb.x * xb.x + xb.y * xb.y) + (xb.z * xb.z + xb.w * xb.w);
                    if (gsn) { const f32x4 ya = xa * sv[bj][0], yb = xb * sv[bj][1]; u32x4 w; w.x = cvt_pk_bf16(ya[0], ya[1]); w.y = cvt_pk_bf16(ya[2], ya[3]); w.z = cvt_pk_bf16(yb[0], yb[1]); w.w = cvt_pk_bf16(yb[2], yb[3]);
                        *(u32x4*)(xs + (size_t)row * 1024 + colb + bj * HALF) = w; }
                }
                if (bj == 0) continue;
                if (gsn) { ss += __shfl_xor(ss, 16); ss += __shfl_xor(ss, 32); if (fq == 0) ssq[(size_t)row * 16 + u.pn * 4 + wc] = ss; }
            }
    }
};

template <class Epi>
__device__ __forceinline__ void gemm_phase(LAS unsigned char* lds, const Gemm g, const StaticOrder& S, const Epi& E) {
    const int tid = otid(), wid = __builtin_amdgcn_readfirstlane(tid >> 6), lane = tid & 63, wr = wid >> 2, wc = wid & 3, fr = lane & 15, fq = lane >> 4;
    const int K = g.K, nt = K / BK;
    unsigned voffA[2], voffB[2];
#pragma unroll
    for (int i = 0; i < 2; ++i) { int R, C; stage_rc(tid * 16 + i * 8192, R, C); const int Rb = (R & ~31) + perm32(R & 31);
        voffA[i] = (unsigned)(R * K + C) * 2u; voffB[i] = (unsigned)(Rb * K + C) * 2u; }
    const size_t kstep = (size_t)(BK * 2);
    const size_t hstep = (size_t)HALF * K * 2;
    const size_t tstep = 2 * hstep;
    const unsigned ldsw = (unsigned)wid * 1024u;
    const int aoff = lds_byte(wr * 64 + fr, fq * 8), boff = lds_byte(wc * 32 + fr, fq * 8);
#define PG8_SA(b, h) (((b) * 2 + (h)) * HTB)
#define PG8_SB(b, h) ((4 + (b) * 2 + (h)) * HTB)
#define PG8_STAGE(bufoff, gbase, voff) do { _Pragma("unroll") for (int _i = 0; _i < 2; ++_i) \
        __builtin_amdgcn_global_load_lds((const unsigned*)((const char*)(gbase) + (voff)[_i]), (LAS unsigned*)(lds + (bufoff) + ldsw + _i * 8192), 16, 0, 0); } while (0)
#define PG8_LDA(dst, b, h) do { _Pragma("unroll") for (int m = 0; m < 4; ++m) _Pragma("unroll") for (int k = 0; k < 2; ++k) dst[m][k] = *(const LAS bf16x8*)(lds + PG8_SA(b, h) + aoff + m * 2048 + k * 1024); } while (0)
#define PG8_LDB(dst, b, h) do { _Pragma("unroll") for (int n = 0; n < 2; ++n) _Pragma("unroll") for (int k = 0; k < 2; ++k) dst[n][k] = *(const LAS bf16x8*)(lds + PG8_SB(b, h) + boff + n * 2048 + k * 1024); } while (0)
#define PG8_MMA(ai, bj, At, Bt) do { __builtin_amdgcn_s_setprio(1); _Pragma("unroll") for (int m = 0; m < 4; ++m) _Pragma("unroll") for (int n = 0; n < 2; ++n) _Pragma("unroll") for (int k = 0; k < 2; ++k) \
        acc[ai][bj][m][n] = __builtin_amdgcn_mfma_f32_16x16x32_bf16(Bt[n][k], At[m][k], acc[ai][bj][m][n], 0, 0, 0); __builtin_amdgcn_s_setprio(0); } while (0)
#define PG8_WAIT_V(n) asm volatile("s_waitcnt vmcnt(" #n ")" ::: "memory")
#define PG8_WAIT_L(n) asm volatile("s_waitcnt lgkmcnt(" #n ")" ::: "memory")
#define PG8_BAR __builtin_amdgcn_s_barrier()
#define PG8_SCHED __builtin_amdgcn_sched_barrier(0)
    Unit cur, nxt; int ui = 0;
    if (!S.next(0, cur)) return;
    f32x4 acc[2][2][4][2];
#pragma unroll
    for (int a = 0; a < 2; ++a)
#pragma unroll
        for (int b = 0; b < 2; ++b)
#pragma unroll
            for (int m = 0; m < 4; ++m)
#pragma unroll
                for (int n = 0; n < 2; ++n) acc[a][b][m][n] = (f32x4){0.f, 0.f, 0.f, 0.f};
    bf16x8 At[4][2], B0[2][2], B1[2][2];
    const char* cA = (const char*)g.A + (size_t)cur.pm * tstep; const char* cB = (const char*)g.Bt + (size_t)cur.pn * tstep;
    PG8_STAGE(PG8_SB(0, 0), cB, voffB); PG8_STAGE(PG8_SB(0, 1), cB + hstep, voffB); PG8_STAGE(PG8_SA(0, 0), cA, voffA); PG8_STAGE(PG8_SA(0, 1), cA + hstep, voffA);
    if (wr == 1) PG8_BAR;
    PG8_WAIT_V(2); PG8_BAR;
    PG8_STAGE(PG8_SB(1, 0), cB + kstep, voffB); PG8_STAGE(PG8_SA(1, 0), cA + kstep, voffA); PG8_STAGE(PG8_SB(1, 1), cB + hstep + kstep, voffB);
    PG8_WAIT_V(6); PG8_BAR;
    for (;;) {
        const bool has_next = S.next(ui + 1, nxt);
        const char* nA = has_next ? (const char*)g.A + (size_t)nxt.pm * tstep : cA; const char* nB = has_next ? (const char*)g.Bt + (size_t)nxt.pn * tstep : cB;
        for (int t = 0; t < nt; t += 2) {
            const bool last = (t == nt - 2);
            const char* a1 = cA + (size_t)(t + 1) * kstep;
            const char* a2 = last ? nA : cA + (size_t)(t + 2) * kstep; const char* b2 = last ? nB : cB + (size_t)(t + 2) * kstep;
            const char* a3 = a2 + kstep; const char* b3 = b2 + kstep;
            PG8_LDB(B0, 0, 0); PG8_LDB(B1, 0, 1); PG8_SCHED; PG8_LDA(At, 0, 0); PG8_STAGE(PG8_SA(1, 1), a1 + hstep, voffA);
            PG8_WAIT_V(8); PG8_WAIT_L(0); PG8_BAR; PG8_MMA(0, 0, At, B0); PG8_MMA(0, 1, At, B1); PG8_BAR; PG8_SCHED;
            PG8_LDA(At, 0, 1); PG8_STAGE(PG8_SB(0, 0), b2, voffB); PG8_STAGE(PG8_SB(0, 1), b2 + hstep, voffB); PG8_STAGE(PG8_SA(0, 0), a2, voffA);
            PG8_WAIT_V(8); PG8_WAIT_L(0); PG8_BAR; PG8_MMA(1, 0, At, B0); PG8_MMA(1, 1, At, B1); PG8_BAR; PG8_SCHED;
            PG8_LDB(B0, 1, 0); PG8_LDB(B1, 1, 1); PG8_SCHED; PG8_LDA(At, 1, 0); PG8_STAGE(PG8_SA(0, 1), a2 + hstep, voffA);
            PG8_WAIT_V(8); PG8_WAIT_L(0); PG8_BAR; PG8_MMA(0, 0, At, B0); PG8_MMA(0, 1, At, B1); PG8_BAR; PG8_SCHED;
            PG8_LDA(At, 1, 1); PG8_STAGE(PG8_SB(1, 0), b3, voffB); PG8_STAGE(PG8_SB(1, 1), b3 + hstep, voffB); PG8_STAGE(PG8_SA(1, 0), a3, voffA);
            PG8_WAIT_V(8); PG8_WAIT_L(0); PG8_BAR; PG8_MMA(1, 0, At, B0); PG8_MMA(1, 1, At, B1); PG8_BAR; PG8_SCHED;
        }
        if (wr == 0) PG8_BAR;
        E(acc, cur, wr, wc, fr, fq);
        if (!has_next) break;
#pragma unroll
        for (int a = 0; a < 2; ++a)
#pragma unroll
            for (int b = 0; b < 2; ++b)
#pragma unroll
                for (int m = 0; m < 4; ++m)
#pragma unroll
                    for (int n = 0; n < 2; ++n) acc[a][b][m][n] = (f32x4){0.f, 0.f, 0.f, 0.f};
        cur = nxt; cA = nA; cB = nB; ++ui;
        if (wr == 1) PG8_BAR;
    }
    PG8_WAIT_V(0);
    PG8_BAR;
#undef PG8_SA
#undef PG8_SB
#undef PG8_STAGE
#undef PG8_LDA
#undef PG8_LDB
#undef PG8_MMA
#undef PG8_WAIT_V
#undef PG8_WAIT_L
#undef PG8_BAR
#undef PG8_SCHED
}
}

__device__ __forceinline__ void transpose_item(const float* W, int K, int N, bf16_t* WT, int row_off, LAS float* scr, int item, int lane) {
    const int nblk = N / 32, kb = item / nblk, nb = item % nblk, k0 = 64 * kb, n0 = 32 * nb;
    { float w[32];
#pragma unroll
      for (int i = 0; i < 32; ++i) w[i] = W[(size_t)(k0 + 2 * i + (lane >> 5)) * N + n0 + (lane & 31)];
#pragma unroll
      for (int i = 0; i < 32; ++i) scr[(2 * i + (lane >> 5)) * 33 + (lane & 31)] = w[i]; }
    asm volatile("s_waitcnt lgkmcnt(0)" ::: "memory");
    const int c = lane & 7;
#pragma unroll
    for (int j = 0; j < 4; ++j) { const int n = (lane >> 3) + 8 * j; const LAS float* s = scr + (8 * c) * 33 + n;
        u32x4 o; o.x = pk2(s[0 * 33], s[1 * 33]); o.y = pk2(s[2 * 33], s[3 * 33]); o.z = pk2(s[4 * 33], s[5 * 33]); o.w = pk2(s[6 * 33], s[7 * 33]);
        *(u32x4*)(WT + (size_t)(row_off + n0 + n) * K + k0 + 8 * c) = o; }
    asm volatile("s_waitcnt lgkmcnt(0)" ::: "memory");
}
__device__ __forceinline__ void do_transposes(const Args& a, LAS unsigned char* lds, int job_lo, int job_hi, int ml, int wblk, int nblk) {
    const int tid = otid(), lane = tid & 63, wave = tid >> 6;
    const int gw = wblk * 8 + wave, NGW = nblk * 8;
    LAS float* scr = (LAS float*)(lds + wave * 16384);
    unsigned char* ws = a.ws;
    int base = 0;
    for (int job = job_lo; job < job_hi; ++job) {
        const float* W; int K, N, roff = 0; bf16_t* dst;
        switch (job) {
            case 0: W = a.in[12]; K = 1024; N = 3072; dst = (bf16_t*)(ws + WS_W + OFF_SCIN0); break;
            case 1: W = a.in[15]; K = 1024; N = 1024; dst = (bf16_t*)(ws + WS_W + OFF_SCOUT0); break;
            case 2: W = a.in[12] + (size_t)1024 * 3072; K = 1024; N = 3072; dst = (bf16_t*)(ws + WS_W + OFF_SCIN1); break;
            case 3: W = a.in[15] + (size_t)1024 * 1024; K = 1024; N = 1024; dst = (bf16_t*)(ws + WS_W + OFF_SCOUT1); break;
            case 4: W = a.in[25]; K = 1024; N = 3072; dst = (bf16_t*)(ws + WS_W + OFF_HYIN); break;
            case 5: W = a.in[37]; K = 1024; N = 1024; dst = (bf16_t*)(ws + WS_W + OFF_HYOUT); break;
            case 6: W = a.in[24]; K = 1024; N = 1024; dst = (bf16_t*)(ws + WS_W + OFF_WO); break;
            case 7: W = a.in[16]; K = 1024; N = 384; dst = (bf16_t*)(ws + WS_W + OFF_DQKV); break;
            case 8: W = a.in[19]; K = 1024; N = 288; dst = (bf16_t*)(ws + WS_W + OFF_DQKV); roff = 384; break;
            case 9: W = a.in[18]; K = 384; N = 1536; dst = (bf16_t*)(ws + WS_W + OFF_WUQ); break;
            case 10: W = a.in[21]; K = 256; N = 2048; dst = (bf16_t*)(ws + WS_W + OFF_WUKV); break;
            case 11: W = a.in[10] + (size_t)ml * 1024 * 4096; K = 1024; N = 4096; dst = (bf16_t*)(ws + WS_MLP1); break;
            default: W = a.in[11] + (size_t)ml * 4096 * 1024; K = 4096; N = 1024; dst = (bf16_t*)(ws + WS_MLP2); break;
        }
        const int items = (K / 64) * (N / 32);
        int start = (gw - base) % NGW; if (start < 0) start += NGW;
        for (int it = start; it < items; it += NGW) transpose_item(W, K, N, dst, roff, scr, it, lane);
        base = (base + items) % NGW;
    }
}

__device__ __forceinline__ void gemv_unit(LAS float* lv, LAS float* red, const float* W, int N, int n0, float* out, int ostride, const float* badd) {
    const int tid = otid(), kg = tid >> 6, cl = tid & 63, n = n0 + cl;
    float a0 = 0.f, a1 = 0.f, a2 = 0.f, a3 = 0.f, a4 = 0.f;
    if (n < N) {
        const float* wp = W + (size_t)(kg * 128) * N + n;
        const LAS float* v = lv + kg * 128;
#pragma unroll 1
        for (int k0 = 0; k0 < 128; k0 += 32) {
            float w[32];
#pragma unroll
            for (int k = 0; k < 32; ++k) w[k] = wp[(size_t)(k0 + k) * N];
#pragma unroll
            for (int k = 0; k < 32; ++k) { a0 += v[k0 + k] * w[k]; a1 += v[1024 + k0 + k] * w[k]; a2 += v[2048 + k0 + k] * w[k]; a3 += v[3072 + k0 + k] * w[k]; a4 += v[4096 + k0 + k] * w[k]; }
        }
    }
    red[(kg * 5 + 0) * 64 + cl] = a0; red[(kg * 5 + 1) * 64 + cl] = a1; red[(kg * 5 + 2) * 64 + cl] = a2; red[(kg * 5 + 3) * 64 + cl] = a3; red[(kg * 5 + 4) * 64 + cl] = a4;
    __syncthreads();
    if (tid < 320) { const int ci = tid >> 6; float s = 0.f;
#pragma unroll
        for (int q = 0; q < 8; ++q) s += red[(q * 5 + ci) * 64 + cl];
        if (n < N) out[(size_t)ci * ostride + n] = s + (badd ? badd[n] : 0.f); }
    __syncthreads();
}

__device__ __forceinline__ void phase0(const Args& a, LAS unsigned char* lds) {
    const int tid = otid(), bid = obid(), lane = tid & 63, wave = tid >> 6, G = ogrid();
    const int gw = bid * 8 + wave, NGW = G * 8, gt = bid * 512 + tid, GT = G * 512;
    unsigned char* ws = a.ws;
    do_transposes(a, lds, 0, 13, 0, obid(), ogrid());
    { u32x4* p = (u32x4*)(ws + WS_W + OFF_DQKV + (size_t)672 * 1024 * 2); for (int i = gt; i < 12288; i += GT) p[i] = (u32x4){0u, 0u, 0u, 0u}; }
    { const float* w0 = a.in[28]; const float* b0 = a.in[29]; const float* w1 = a.in[30]; const float* b1 = a.in[31]; const float* w2 = a.in[32]; const float* b2 = a.in[33]; const float frq = a.in[35][lane];
      float* A3 = (float*)(ws + WS_A3);
      for (int pos = gw; pos < 4352; pos += NGW) {
          const int n = pos < 256 ? 256 : 4096, t = pos < 256 ? pos : pos - 256;
          const float t01 = (float)t / (float)(n - 1), w = 6.283185307179586f * (float)t / (float)n;
          float z = 0.f;
          if (lane == 0) z = t01;
          else if (lane <= 32) { const int i = (lane - 1) & 15; const float fb = 1e-4f + (15.0f - 1e-4f) * (float)i / 15.0f; z = lane <= 16 ? cosf(fb * w) : -sinf(fb * w); }
          float acc = b0[lane];
#pragma unroll
          for (int e = 0; e < 33; ++e) acc += __shfl(z, e) * w0[e * 64 + lane];
          const float h1 = sinf(frq * acc);
          acc = b1[lane];
#pragma unroll 16
          for (int k = 0; k < 64; ++k) acc += __shfl(h1, k) * w1[k * 64 + lane];
          const float h2 = sinf(frq * acc);
          acc = b2[lane];
#pragma unroll 16
          for (int k = 0; k < 64; ++k) acc += __shfl(h2, k) * w2[k * 64 + lane];
          A3[(size_t)pos * 64 + lane] = sinf(frq * acc);
      } }
    __syncthreads();
    LAS float* lv = (LAS float*)lds; LAS float* red = (LAS float*)(lds + 20480);
    for (int i = tid; i < 5120; i += 512) { const int ci = i >> 10, k = i & 1023; const float c = ci == 0 ? a.in[5][k] : a.in[4][(ci - 1) * 1024 + k]; lv[i] = c / (1.f + expf(-c)); }
    __syncthreads();
    float* MODV = (float*)(ws + WS_MODV);
    for (int u = bid; u < 4 * 96; u += G) { const int l = u / 96, n0 = (u % 96) * 64;
        gemv_unit(lv, red, a.in[8] + (size_t)l * 1024 * 6144, 6144, n0, MODV + (size_t)l * 5 * 6144, 6144, a.in[9] + (size_t)l * 6144); }
}

__device__ __forceinline__ void hfb_unit(const Args& a, LAS unsigned char* lds, int unit);
__device__ __forceinline__ void phase1(const Args& a, LAS unsigned char* lds) {
    const int tid = otid(), bid = obid(), lane = tid & 63, wave = tid >> 6, G = ogrid();
    const int gw = bid * 8 + wave, NGW = G * 8, gt = bid * 512 + tid, GT = G * 512;
    unsigned char* ws = a.ws;
    const float* MODV = (const float*)(ws + WS_MODV);
    float* GS = (float*)(ws + WS_GS);
    for (int i = gt; i < 8 * 5 * 1024; i += GT) { const int k = i & 1023, ci = (i >> 10) % 5, lw = i / 5120, l = lw >> 1, w = lw & 1;
        const float gn = (w ? a.in[7] : a.in[6])[l * 1024 + k]; GS[i] = gn * (1.f + MODV[(size_t)(l * 5 + ci) * 6144 + (w ? 4 : 1) * 1024 + k]); }
    { float* BZ = (float*)(ws + WS_BIAS) + B_DQKV; for (int i = gt; i < 5 * 96; i += GT) BZ[(i / 96) * 768 + 672 + (i % 96)] = 0.f; }
    bf16_t* XS = (bf16_t*)(ws + WS_XS); float* SSQ = (float*)(ws + WS_SSQ);
    for (int m0 = gw; m0 < M; m0 += 4 * NGW) {
        f32x4 v[4][4];
#pragma unroll
        for (int q = 0; q < 4; ++q) { const int m = m0 + q * NGW; if (m < M) { const float* xr = m < MP ? a.in[0] + (size_t)m * D : a.in[1] + (size_t)(m - MP) * D;
#pragma unroll
            for (int j = 0; j < 4; ++j) v[q][j] = ((const f32x4*)xr)[lane + 64 * j]; } }
#pragma unroll
        for (int q = 0; q < 4; ++q) { const int m = m0 + q * NGW; if (m < M) {
            const int ci = m < MP ? 0 : 1 + ((m - MP) >> 12);
            const float* sc = MODV + (size_t)ci * 6144 + 1024;
            float s = 0.f;
#pragma unroll
            for (int j = 0; j < 4; ++j) s += (v[q][j].x * v[q][j].x + v[q][j].y * v[q][j].y) + (v[q][j].z * v[q][j].z + v[q][j].w * v[q][j].w);
            s = wave_sum(s);
#pragma unroll
            for (int j = 0; j < 4; ++j) {
                const f32x4 gn = ((const f32x4*)a.in[6])[lane + 64 * j]; const f32x4 sv = ((const f32x4*)sc)[lane + 64 * j];
                const f32x4 y = v[q][j] * gn * (sv + 1.f);
                u32x2 o; o.x = pk2(y.x, y.y); o.y = pk2(y.z, y.w);
                ((u32x2*)(XS + (size_t)m * D))[lane + 64 * j] = o;
            }
            if (lane < 16) SSQ[(size_t)m * 16 + lane] = lane == 0 ? s : 0.f; } }
    }
    __syncthreads();
    LAS float* lv = (LAS float*)lds; LAS float* red = (LAS float*)(lds + 20480);
    float* BIAS = (float*)(ws + WS_BIAS);
    for (int u = bid; u < 411; u += G) {
        int r = u; const float* W; int N, l, wh, ostride; float* out;
        if (r < 48) { W = a.in[12]; N = 3072; l = 0; wh = 0; out = BIAS + B_IN0; ostride = 3072; }
        else if ((r -= 48) < 64) { W = a.in[10]; N = 4096; l = 0; wh = 1; out = BIAS + B_M0; ostride = 4096; }
        else if ((r -= 64) < 6) { W = a.in[16]; N = 384; l = 1; wh = 0; out = BIAS + B_DQKV; ostride = 768; }
        else if ((r -= 6) < 5) { W = a.in[19]; N = 288; l = 1; wh = 0; out = BIAS + B_DQKV + 384; ostride = 768; }
        else if ((r -= 5) < 64) { W = a.in[10] + (size_t)1 * 1024 * 4096; N = 4096; l = 1; wh = 1; out = BIAS + B_M1; ostride = 4096; }
        else if ((r -= 64) < 48) { W = a.in[25]; N = 3072; l = 2; wh = 0; out = BIAS + B_HY; ostride = 3072; }
        else if ((r -= 48) < 64) { W = a.in[10] + (size_t)2 * 1024 * 4096; N = 4096; l = 2; wh = 1; out = BIAS + B_M2; ostride = 4096; }
        else if ((r -= 64) < 48) { W = a.in[12] + (size_t)1024 * 3072; N = 3072; l = 3; wh = 0; out = BIAS + B_IN3; ostride = 3072; }
        else { r -= 48; W = a.in[10] + (size_t)3 * 1024 * 4096; N = 4096; l = 3; wh = 1; out = BIAS + B_M3; ostride = 4096; }
        for (int i = tid; i < 5120; i += 512) { const int ci = i >> 10, k = i & 1023; lv[i] = MODV[(size_t)(l * 5 + ci) * 6144 + (wh ? 3 : 0) * 1024 + k]; }
        __syncthreads();
        gemv_unit(lv, red, W, N, r * 64, out, ostride, nullptr);
    }
    __syncthreads();
    for (int u = bid; u < 68 * 16; u += G) hfb_unit(a, lds, u);
}

__device__ __forceinline__ void sc_conv_phase(const Args& a, int j) {
    const int gt = obid() * 512 + otid(), GT = ogrid() * 512;
    const bf16_t* U3 = (const bf16_t*)(a.ws + WS_AR); bf16_t* Z = (bf16_t*)(a.ws + WS_Z);
    const float* cw = a.in[13] + (size_t)j * 3 * 1024; const float* cb = a.in[14] + (size_t)j * 1024;
    for (int it = gt; it < (M / 8) * 128; it += GT) {
        const int cgp = it & 127, rb = it >> 7, c = cgp * 8, row0 = rb * 8;
        const int L = row0 < MP ? 256 : 4096, t0 = row0 < MP ? (row0 & 255) : ((row0 - MP) & 4095);
        float w0[8], w1[8], w2[8], bb[8];
#pragma unroll
        for (int i = 0; i < 8; i += 4) { const f32x4 a0 = *(const f32x4*)(cw + c + i), a1 = *(const f32x4*)(cw + 1024 + c + i), a2 = *(const f32x4*)(cw + 2048 + c + i), a3 = *(const f32x4*)(cb + c + i);
#pragma unroll
            for (int e = 0; e < 4; ++e) { w0[i + e] = a0[e]; w1[i + e] = a1[e]; w2[i + e] = a2[e]; bb[i + e] = a3[e]; } }
        u32x4 rx[10], ry[10], rg[8];
#pragma unroll
        for (int q = 0; q < 10; ++q) { const int tq = t0 - 1 + q; const int rr = (tq >= 0 && tq < L) ? row0 - 1 + q : row0;
            rx[q] = *(const u32x4*)(U3 + (size_t)rr * 3072 + 1024 + c); ry[q] = *(const u32x4*)(U3 + (size_t)rr * 3072 + 2048 + c); }
#pragma unroll
        for (int r = 0; r < 8; ++r) rg[r] = *(const u32x4*)(U3 + (size_t)(row0 + r) * 3072 + c);
        float prev[8], cur[8], nxt[8];
        auto prod = [&](int q, float (&p)[8]) { float x[8], y[8]; unpack8(rx[q], x); unpack8(ry[q], y); const int tq = t0 - 1 + q; const float m = (tq >= 0 && tq < L) ? 1.f : 0.f;
#pragma unroll
            for (int i = 0; i < 8; ++i) p[i] = x[i] * y[i] * m; };
        prod(0, prev); prod(1, cur);
#pragma unroll
        for (int r = 0; r < 8; ++r) {
            prod(r + 2, nxt);
            float bg[8], o[8]; unpack8(rg[r], bg);
#pragma unroll
            for (int i = 0; i < 8; ++i) { o[i] = bg[i] * (w0[i] * prev[i] + w1[i] * cur[i] + w2[i] * nxt[i] + bb[i]); prev[i] = cur[i]; cur[i] = nxt[i]; }
            *(u32x4*)(Z + (size_t)(row0 + r) * 1024 + c) = pack8(o);
        }
    }
}

__device__ __forceinline__ void mla_latent_phase(const Args& a) {
    const int tid_ = otid(), lane = tid_ & 63, wave = tid_ >> 6, gw = obid() * 8 + wave, NGW = ogrid() * 8;
    const float* QKVL = (const float*)(a.ws + WS_AR + AR_QKVL);
    bf16_t* CQ = (bf16_t*)(a.ws + WS_AR + AR_CQ); bf16_t* CKV = (bf16_t*)(a.ws + WS_AR + AR_CKV); float* KPE = (float*)(a.ws + WS_AR + AR_KPE);
    const float* qg = a.in[17]; const float* kvg = a.in[20];
    { const int gt = obid() * 512 + tid_, GT = ogrid() * 512;
      const f32x4* src = (const f32x4*)a.in[2]; u32x2* dst = (u32x2*)(CKV + (size_t)M * 256);
      for (int i = gt; i < NCACHE * 256 / 4; i += GT) { const f32x4 v = src[i]; u32x2 o; o.x = pk2(v.x, v.y); o.y = pk2(v.z, v.w); dst[i] = o; }
      const f32x4* s2 = (const f32x4*)a.in[3]; f32x4* d2 = (f32x4*)(KPE + (size_t)M * 32);
      for (int i = gt; i < NCACHE * 32 / 4; i += GT) d2[i] = s2[i]; }
    for (int m0 = gw; m0 < M; m0 += 4 * NGW) {
        f32x2 qv[4][3]; f32x4 kvv[4]; float pev[4];
#pragma unroll
        for (int q4 = 0; q4 < 4; ++q4) { const int m = m0 + q4 * NGW; if (m < M) { const float* r = QKVL + (size_t)m * 768;
#pragma unroll
            for (int j = 0; j < 3; ++j) qv[q4][j] = *(const f32x2*)(r + 2 * lane + 128 * j);
            kvv[q4] = *(const f32x4*)(r + 384 + 4 * lane); pev[q4] = lane < 32 ? r[640 + lane] : 0.f; } }
#pragma unroll
        for (int q4 = 0; q4 < 4; ++q4) { const int m = m0 + q4 * NGW; if (m < M) {
            float s = 0.f;
#pragma unroll
            for (int j = 0; j < 3; ++j) s += qv[q4][j].x * qv[q4][j].x + qv[q4][j].y * qv[q4][j].y;
            const f32x4 kv = kvv[q4];
            float s2 = (kv.x * kv.x + kv.y * kv.y) + (kv.z * kv.z + kv.w * kv.w);
            const float pe = pev[q4];
            s = wave_sum(s); s2 = wave_sum(s2);
            const float rq = rsqrtf(s * (1.0f / 384.0f) + EPS), rk = rsqrtf(s2 * (1.0f / 256.0f) + EPS);
#pragma unroll
            for (int j = 0; j < 3; ++j) { const f32x2 gq = *(const f32x2*)(qg + 2 * lane + 128 * j); *(unsigned*)(CQ + (size_t)m * 384 + 2 * lane + 128 * j) = pk2(qv[q4][j].x * rq * gq.x, qv[q4][j].y * rq * gq.y); }
            const f32x4 gk = *(const f32x4*)(kvg + 4 * lane); const f32x4 kn = kv * rk * gk;
            u32x2 o; o.x = pk2(kn.x, kn.y); o.y = pk2(kn.z, kn.w); *(u32x2*)(CKV + (size_t)m * 256 + 4 * lane) = o;
            if (m < MP) *(f32x4*)(a.out + OUT_CKV + (size_t)m * 256 + 4 * lane) = kn;
            if (lane < 32) { KPE[(size_t)m * 32 + lane] = pe; if (m < MP) a.out[OUT_KPE + (size_t)m * 32 + lane] = pe; } } }
    }
}

__device__ __forceinline__ void normrope(float (&x)[16], float (&tl)[8], const float* gain, int j, bool rope, int t, float scale, const LAS f32x2* rt) {
    float ss = 0.f;
#pragma unroll
    for (int i = 0; i < 16; ++i) ss += x[i] * x[i];
#pragma unroll
    for (int i = 0; i < 8; ++i) ss += tl[i] * tl[i];
    ss += __shfl_xor(ss, 1); ss += __shfl_xor(ss, 2);
    const float rs = rsqrtf(ss * (1.0f / 96.0f) + EPS) ;
#pragma unroll
    for (int i = 0; i < 16; i += 4) { const f32x4 gq = *(const f32x4*)(gain + j * 16 + i);
#pragma unroll
        for (int e = 0; e < 4; ++e) x[i + e] = x[i + e] * rs * gq[e] * scale; }
#pragma unroll
    for (int i = 0; i < 8; i += 4) { const f32x4 gq = *(const f32x4*)(gain + 64 + j * 8 + i);
#pragma unroll
        for (int e = 0; e < 4; ++e) tl[i + e] = tl[i + e] * rs * gq[e]; }
    if (rope) {
        const int pos = (j < 2) ? (t >> 6) : (t & 63);
#pragma unroll
        for (int i = 0; i < 8; ++i) {
            const float partner = __shfl_xor(tl[i], 1);
            const f32x2 cssn = rt[pos * 8 + i];
            tl[i] = (j & 1) ? (tl[i] * cssn.x + partner * cssn.y) : (tl[i] * cssn.x - partner * cssn.y);
        }
    }
#pragma unroll
    for (int i = 0; i < 8; ++i) tl[i] *= scale;
}
__device__ __forceinline__ void kq_finalize_phase(const Args& a, LAS unsigned char* lds) {
    const int tid_ = otid(), lane = tid_ & 63, wave = tid_ >> 6, gw = obid() * 8 + wave, NGW = ogrid() * 8;
    const int h = lane >> 2, j = lane & 3;
    bf16_t* KV = (bf16_t*)(a.ws + WS_AR + AR_KV); const float* KPE = (const float*)(a.ws + WS_AR + AR_KPE); bf16_t* Q = (bf16_t*)(a.ws + WS_XS);
    const float QSCALE = 0.10206207261596575f * 1.4426950408889634f;
    LAS f32x2* rt = (LAS f32x2*)(lds + 135168);
    { const int pos = tid_ >> 3, i = tid_ & 7; const float ang = (float)pos * exp2f(-(float)i * 1.6609640474436813f); rt[tid_] = (f32x2){cosf(ang), sinf(ang)}; }
    __syncthreads();
    constexpr int RB = 4;
    for (int it0 = gw; it0 < MKV; it0 += RB * NGW) {
        u32x4 xa[RB], xb[RB]; f32x4 pa[RB], pb[RB];
#pragma unroll
        for (int q = 0; q < RB; ++q) { const int r = it0 + q * NGW; if (r < MKV) { const bf16_t* base = KV + (size_t)r * 2560 + h * 160;
            xa[q] = *(const u32x4*)(base + j * 16); xb[q] = *(const u32x4*)(base + j * 16 + 8);
            pa[q] = *(const f32x4*)(KPE + (size_t)r * 32 + j * 8); pb[q] = *(const f32x4*)(KPE + (size_t)r * 32 + j * 8 + 4); } }
#pragma unroll
        for (int q = 0; q < RB; ++q) { const int r = it0 + q * NGW; if (r < MKV) { bf16_t* base = KV + (size_t)r * 2560 + h * 160;
            float x[16], tl[8], t8[8];
            unpack8(xa[q], t8);
#pragma unroll
            for (int i = 0; i < 8; ++i) x[i] = t8[i];
            unpack8(xb[q], t8);
#pragma unroll
            for (int i = 0; i < 8; ++i) x[8 + i] = t8[i];
            tl[0] = pa[q].x; tl[1] = pa[q].y; tl[2] = pa[q].z; tl[3] = pa[q].w; tl[4] = pb[q].x; tl[5] = pb[q].y; tl[6] = pb[q].z; tl[7] = pb[q].w;
            normrope(x, tl, a.in[23], j, (r >= MP) && (r < M), (r - MP) & 4095, 1.0f, rt);
            float o8[8];
#pragma unroll
            for (int i = 0; i < 8; ++i) o8[i] = x[i];
            *(u32x4*)(base + j * 16) = pack8(o8);
#pragma unroll
            for (int i = 0; i < 8; ++i) o8[i] = x[8 + i];
            *(u32x4*)(base + j * 16 + 8) = pack8(o8);
            *(u32x4*)(base + 128 + j * 8) = pack8(tl); } }
    }
}

__device__ __forceinline__ void k_finalize_own_units(const Args& a, LAS unsigned char* lds, const pg8::StaticOrder& S) {
    const int tid = otid(), j = tid & 3;
    bf16_t* KV = (bf16_t*)(a.ws + WS_AR + AR_KV); const float* KPE = (const float*)(a.ws + WS_AR + AR_KPE);
    LAS f32x2* rt = (LAS f32x2*)(lds + 135168);
    { const int pos = tid >> 3, i = tid & 7; const float ang = (float)pos * exp2f(-(float)i * 1.6609640474436813f); rt[tid] = (f32x2){cosf(ang), sinf(ang)}; }
    asm volatile("s_waitcnt vmcnt(0)" ::: "memory");
    __syncthreads();
    pg8::Unit u;
    for (int i = 0; S.next(i, u); ++i) {
        unsigned long long xr[4][4]; f32x4 pa[4], pb[4];
#pragma unroll
        for (int it = 0; it < 4; ++it) { const int pi = (it * 512 + tid) >> 2, r = u.pm * 256 + (pi >> 1), h = 2 * u.pn + (pi & 1);
            const unsigned long long* base = (const unsigned long long*)(KV + (size_t)r * 2560 + h * 160 + j * 16);
#pragma unroll
            for (int q = 0; q < 4; ++q) xr[it][q] = __hip_atomic_load(base + q, __ATOMIC_RELAXED, __HIP_MEMORY_SCOPE_AGENT);
            pa[it] = *(const f32x4*)(KPE + (size_t)r * 32 + j * 8); pb[it] = *(const f32x4*)(KPE + (size_t)r * 32 + j * 8 + 4); }
#pragma unroll
        for (int it = 0; it < 4; ++it) { const int pi = (it * 512 + tid) >> 2, r = u.pm * 256 + (pi >> 1), h = 2 * u.pn + (pi & 1);
            bf16_t* base = KV + (size_t)r * 2560 + h * 160;
            float x[16], tl[8], t8[8];
            unpack8((u32x4){(unsigned)xr[it][0], (unsigned)(xr[it][0] >> 32), (unsigned)xr[it][1], (unsigned)(xr[it][1] >> 32)}, t8);
#pragma unroll
            for (int e = 0; e < 8; ++e) x[e] = t8[e];
            unpack8((u32x4){(unsigned)xr[it][2], (unsigned)(xr[it][2] >> 32), (unsigned)xr[it][3], (unsigned)(xr[it][3] >> 32)}, t8);
#pragma unroll
            for (int e = 0; e < 8; ++e) x[8 + e] = t8[e];
            tl[0] = pa[it].x; tl[1] = pa[it].y; tl[2] = pa[it].z; tl[3] = pa[it].w; tl[4] = pb[it].x; tl[5] = pb[it].y; tl[6] = pb[it].z; tl[7] = pb[it].w;
            normrope(x, tl, a.in[23], j, (r >= MP) && (r < M), (r - MP) & 4095, 1.0f, rt);
            float o8[8];
#pragma unroll
            for (int e = 0; e < 8; ++e) o8[e] = x[e];
            *(u32x4*)(base + j * 16) = pack8(o8);
#pragma unroll
            for (int e = 0; e < 8; ++e) o8[e] = x[8 + e];
            *(u32x4*)(base + j * 16 + 8) = pack8(o8);
            *(u32x4*)(base + 128 + j * 8) = pack8(tl); }
    }
}

__device__ __forceinline__ void v_transpose_phase(const Args& a, LAS unsigned char* lds) {
    const int tid = otid(), lane = tid & 63, wave = tid >> 6, gw = obid() * 8 + wave, NGW = ogrid() * 8;
    bf16_t* KV = (bf16_t*)(a.ws + WS_AR + AR_KV);
    LAS unsigned short* scr = (LAS unsigned short*)(lds + wave * 16384);
    const int r8 = lane >> 3, c8 = lane & 7;
    for (int it = gw; it < (MKV / 64) * 16; it += NGW) {
        const int kb = it >> 4, h = it & 15;
        bf16_t* base = KV + (size_t)(kb * 64) * 2560 + h * 160 + 64;
        u32x4 v[8];
#pragma unroll
        for (int i = 0; i < 8; ++i) v[i] = *(const u32x4*)(base + (size_t)(r8 + 8 * i) * 2560 + c8 * 8);
#pragma unroll
        for (int i = 0; i < 8; ++i) { LAS unsigned* p = (LAS unsigned*)(scr + (r8 + 8 * i) * 66 + c8 * 8); p[0] = v[i].x; p[1] = v[i].y; p[2] = v[i].z; p[3] = v[i].w; }
        asm volatile("s_waitcnt lgkmcnt(0)" ::: "memory");
#pragma unroll
        for (int i = 0; i < 8; ++i) { const int d = r8 + 8 * i; const LAS unsigned short* q = scr + (c8 * 8) * 66 + d;
            u32x4 o; o.x = (unsigned)q[0] | ((unsigned)q[66] << 16); o.y = (unsigned)q[2 * 66] | ((unsigned)q[3 * 66] << 16);
            o.z = (unsigned)q[4 * 66] | ((unsigned)q[5 * 66] << 16); o.w = (unsigned)q[6 * 66] | ((unsigned)q[7 * 66] << 16);
            *(u32x4*)(base + (size_t)d * 2560 + c8 * 8) = o; }
        asm volatile("s_waitcnt lgkmcnt(0)" ::: "memory");
    }
}

template <int OFF> __device__ __forceinline__ u32x2 tr_read(unsigned vb) {
    u32x2 r; asm volatile("ds_read_b64_tr_b16 %0, %1 offset:%2" : "=&v"(r) : "v"(vb), "i"(OFF) : "memory"); return r;
}
constexpr int KS_PITCH = 208, VT_PITCH = 144, VT_OFF = 64 * KS_PITCH, ST_BYTES = 64 * KS_PITCH + 64 * VT_PITCH, ROPE_OFF = 65536;
__device__ __forceinline__ void attn_unit(const Args& a, LAS unsigned char* lds, int u, float kbound) {
    const int tid = otid(), lane = tid & 63, wave = tid >> 6, fr = lane & 15, fq = lane >> 4;
    const bf16_t* KV = (const bf16_t*)(a.ws + WS_AR + AR_KV); const bf16_t* Q = (const bf16_t*)(a.ws + WS_XS); bf16_t* AO = (bf16_t*)(a.ws + WS_AR + AR_AO);
    int b, h, row0, nt; bool smp;
    if (u < 1024) { smp = true; const int bh = u >> 4, qb = u & 15; b = bh >> 4; h = bh & 15; row0 = MP + b * 4096 + qb * 256; nt = 72; }
    else { smp = false; const int v = u - 1024; b = v >> 4; h = v & 15; row0 = b * 256; nt = 4; }
    bf16x8 qf[2][3]; float mb[2];
    const float* qg = a.in[22];
    const LAS f32x2* rt = (const LAS f32x2*)(lds + ROPE_OFF);
    const float QSCALE = 0.10206207261596575f * 1.4426950408889634f;
#pragma unroll
    for (int qt = 0; qt < 2; ++qt) {
        const int row = row0 + wave * 32 + qt * 16 + fr;
        float f[3][8]; float ss = 0.f;
#pragma unroll
        for (int ks = 0; ks < 3; ++ks) { unpack8(*(const u32x4*)(Q + (size_t)row * 1536 + h * 96 + ks * 32 + fq * 8), f[ks]);
#pragma unroll
            for (int i = 0; i < 8; ++i) ss += f[ks][i] * f[ks][i]; }
        ss += __shfl_xor(ss, 16); ss += __shfl_xor(ss, 32);
        const float rs = rsqrtf(ss * (1.0f / 96.0f) + EPS);
#pragma unroll
        for (int ks = 0; ks < 3; ++ks) { const f32x4 g0 = *(const f32x4*)(qg + ks * 32 + fq * 8), g1 = *(const f32x4*)(qg + ks * 32 + fq * 8 + 4);
#pragma unroll
            for (int i = 0; i < 4; ++i) { f[ks][i] *= rs * g0[i]; f[ks][4 + i] *= rs * g1[i]; } }
        if (smp) {
            const int t = (row - MP) & 4095, pos = (fq < 2) ? (t >> 6) : (t & 63);
#pragma unroll
            for (int i = 0; i < 8; ++i) { const float partner = __shfl_xor(f[2][i], 16); const f32x2 cssn = rt[pos * 8 + i];
                f[2][i] = (fq & 1) ? (f[2][i] * cssn.x + partner * cssn.y) : (f[2][i] * cssn.x - partner * cssn.y); }
        }
        float s2 = 0.f;
#pragma unroll
        for (int ks = 0; ks < 3; ++ks) {
#pragma unroll
            for (int i = 0; i < 8; ++i) f[ks][i] *= QSCALE;
            const u32x4 w = pack8(f[ks]); qf[qt][ks] = __builtin_bit_cast(bf16x8, w);
            float r8[8]; unpack8(w, r8);
#pragma unroll
            for (int i = 0; i < 8; ++i) s2 += r8[i] * r8[i]; }
        s2 += __shfl_xor(s2, 16); s2 += __shfl_xor(s2, 32);
        mb[qt] = sqrtf(s2) * kbound;
    }
    f32x4 O[4][2]; float lrun[2];
#pragma unroll
    for (int dt = 0; dt < 4; ++dt)
#pragma unroll
        for (int qt = 0; qt < 2; ++qt) O[dt][qt] = (f32x4){0.f, 0.f, 0.f, 0.f};
    lrun[0] = lrun[1] = 0.f;
    const int kkey0 = tid / 12, kch0 = tid % 12, kkey1 = (tid + 512) / 12, kch1 = (tid + 512) % 12;
    const int kco0 = kch0 < 8 ? kch0 * 8 : 128 + (kch0 - 8) * 8, kco1 = kch1 < 8 ? kch1 * 8 : 128 + (kch1 - 8) * 8;
    const int vd = tid >> 3, vch = tid & 7;
    u32x4 kr0, kr1 = (u32x4){0u, 0u, 0u, 0u}, vr;
    auto tile_row = [&](int jt) -> int { return smp ? (jt < 64 ? MP + b * 4096 + jt * 64 : M + b * 512 + (jt - 64) * 64) : b * 256 + jt * 64; };
    auto gload = [&](int jt) { const int kr = tile_row(jt);
        kr0 = *(const u32x4*)(KV + (size_t)(kr + kkey0) * 2560 + h * 160 + kco0);
        if (tid < 256) kr1 = *(const u32x4*)(KV + (size_t)(kr + kkey1) * 2560 + h * 160 + kco1);
        vr = *(const u32x4*)(KV + (size_t)(kr + vd) * 2560 + h * 160 + 64 + vch * 8); };
    auto swrite = [&](int st) { LAS unsigned char* sb = lds + st * ST_BYTES;
        *(LAS u32x4*)(sb + kkey0 * KS_PITCH + kch0 * 16) = kr0;
        if (tid < 256) *(LAS u32x4*)(sb + kkey1 * KS_PITCH + kch1 * 16) = kr1;
        *(LAS u32x4*)(sb + VT_OFF + vd * VT_PITCH + vch * 16) = vr; };
    gload(0); swrite(0);
    __syncthreads();
    for (int jt = 0; jt < nt; ++jt) {
        const LAS unsigned char* sb = lds + (jt & 1) * ST_BYTES;
        if (jt + 1 < nt) gload(jt + 1);
        bf16x8 kf[3][4];
#pragma unroll
        for (int ks = 0; ks < 3; ++ks)
#pragma unroll
            for (int kt = 0; kt < 4; ++kt) kf[ks][kt] = *(const LAS bf16x8*)(sb + (kt * 16 + fr) * KS_PITCH + ks * 64 + fq * 16);
        __builtin_amdgcn_sched_barrier(0);
        f32x4 S[4][2];
#pragma unroll
        for (int kt = 0; kt < 4; ++kt)
#pragma unroll
            for (int qt = 0; qt < 2; ++qt) S[kt][qt] = (f32x4){-mb[qt], -mb[qt], -mb[qt], -mb[qt]};
#pragma unroll
        for (int ks = 0; ks < 3; ++ks)
#pragma unroll
            for (int kt = 0; kt < 4; ++kt)
#pragma unroll
                for (int qt = 0; qt < 2; ++qt) S[kt][qt] = __builtin_amdgcn_mfma_f32_16x16x32_bf16(kf[ks][kt], qf[qt][ks], S[kt][qt], 0, 0, 0);
        u32x2 vlo[2][4], vhi[2][4];
        { const unsigned vb = (unsigned)(size_t)(sb + VT_OFF) + (unsigned)((fq * 4 + (fr >> 2)) * VT_PITCH + (fr & 3) * 8);
          vlo[0][0] = tr_read<0 * 32>(vb);  vhi[0][0] = tr_read<16 * VT_PITCH + 0 * 32>(vb);
          vlo[0][1] = tr_read<1 * 32>(vb);  vhi[0][1] = tr_read<16 * VT_PITCH + 1 * 32>(vb);
          vlo[0][2] = tr_read<2 * 32>(vb);  vhi[0][2] = tr_read<16 * VT_PITCH + 2 * 32>(vb);
          vlo[0][3] = tr_read<3 * 32>(vb);  vhi[0][3] = tr_read<16 * VT_PITCH + 3 * 32>(vb);
          vlo[1][0] = tr_read<32 * VT_PITCH + 0 * 32>(vb);  vhi[1][0] = tr_read<48 * VT_PITCH + 0 * 32>(vb);
          vlo[1][1] = tr_read<32 * VT_PITCH + 1 * 32>(vb);  vhi[1][1] = tr_read<48 * VT_PITCH + 1 * 32>(vb);
          vlo[1][2] = tr_read<32 * VT_PITCH + 2 * 32>(vb);  vhi[1][2] = tr_read<48 * VT_PITCH + 2 * 32>(vb);
          vlo[1][3] = tr_read<32 * VT_PITCH + 3 * 32>(vb);  vhi[1][3] = tr_read<48 * VT_PITCH + 3 * 32>(vb); }
        __builtin_amdgcn_sched_barrier(0);
        bf16x8 pf[2][2];
#pragma unroll
        for (int qt = 0; qt < 2; ++qt) {
            float rsum = 0.f;
#pragma unroll
            for (int kt = 0; kt < 4; ++kt)
#pragma unroll
                for (int e = 0; e < 4; ++e) { const float p = __builtin_amdgcn_exp2f(S[kt][qt][e]); rsum += p; S[kt][qt][e] = p; }
            lrun[qt] += rsum;
#pragma unroll
            for (int kk = 0; kk < 2; ++kk) {
                u32x4 w; w.x = cvt_pk_bf16(S[2 * kk][qt][0], S[2 * kk][qt][1]); w.y = cvt_pk_bf16(S[2 * kk][qt][2], S[2 * kk][qt][3]);
                w.z = cvt_pk_bf16(S[2 * kk + 1][qt][0], S[2 * kk + 1][qt][1]); w.w = cvt_pk_bf16(S[2 * kk + 1][qt][2], S[2 * kk + 1][qt][3]);
                pf[qt][kk] = __builtin_bit_cast(bf16x8, w);
            }
        }
        asm volatile("s_waitcnt lgkmcnt(0)" ::: "memory");
        __builtin_amdgcn_sched_barrier(0);
#pragma unroll
        for (int kk = 0; kk < 2; ++kk)
#pragma unroll
            for (int dt = 0; dt < 4; ++dt) {
                u32x4 w; w.x = vlo[kk][dt].x; w.y = vlo[kk][dt].y; w.z = vhi[kk][dt].x; w.w = vhi[kk][dt].y;
                const bf16x8 af = __builtin_bit_cast(bf16x8, w);
#pragma unroll
                for (int qt = 0; qt < 2; ++qt) O[dt][qt] = __builtin_amdgcn_mfma_f32_16x16x32_bf16(af, pf[qt][kk], O[dt][qt], 0, 0, 0);
            }
        if (jt + 1 < nt) swrite((jt + 1) & 1);
        __syncthreads();
    }
#pragma unroll
    for (int qt = 0; qt < 2; ++qt) {
        float l = lrun[qt]; l += __shfl_xor(l, 16); l += __shfl_xor(l, 32);
        const float inv = 1.0f / l;
        bf16_t* op = AO + (size_t)(row0 + wave * 32 + qt * 16 + fr) * 1024 + h * 64 + fq * 4;
#pragma unroll
        for (int dt = 0; dt < 4; ++dt) { const f32x4 o = O[dt][qt] * inv; u32x2 w; w.x = pk2(o.x, o.y); w.y = pk2(o.z, o.w); *(u32x2*)(op + dt * 16) = w; }
    }
}
__device__ __forceinline__ void attn_phase(const Args& a, LAS unsigned char* lds, int bx) {
    const int G = ogrid();
    const int vcu = (G % 8 == 0) ? (bx % 8) * (G / 8) + bx / 8 : bx;
    float gmax = 0.f;
    for (int i = 0; i < 96; ++i) gmax = fmaxf(gmax, fabsf(a.in[23][i]));
    { const int tid = otid(); LAS f32x2* rtw = (LAS f32x2*)(lds + ROPE_OFF); const int pos = tid >> 3, i = tid & 7;
      const float ang = (float)pos * exp2f(-(float)i * 1.6609640474436813f); rtw[tid] = (f32x2){cosf(ang), sinf(ang)}; }
    __syncthreads();
    const float kbound = 9.797958971132712f * gmax * 1.01f;
    for (int u = vcu; u < 1536; u += G) attn_unit(a, lds, u, kbound);
}

#define FPAD(i) ((i) + ((i) >> 4))
constexpr int TW_OFF = (8192 + 512) * 8, TW_R13 = 1365, TW_R9 = 1365 + 4096, TW_N = 1365 + 4096 + 256;
__device__ __forceinline__ void build_twiddles(LAS unsigned char* lds, int tid) {
    LAS f32x2* tw = (LAS f32x2*)(lds + TW_OFF);
    for (int j = tid; j < TW_N; j += 512) {
        float ang;
        if (j < TW_R13) { int off = 0, p = 1; while (j >= off + p) { off += p; p <<= 2; } ang = -(float)(j - off) / (float)(2 * p); }
        else if (j < TW_R9) ang = -(float)(j - TW_R13) * (1.0f / 4096.0f);
        else ang = -(float)(j - TW_R9) * (1.0f / 256.0f);
        float sn, cs; sincospif(ang, &sn, &cs); tw[j] = (f32x2){cs, sn};
    }
    __syncthreads();
}
__device__ __forceinline__ void r4bf(const f32x2 a0, f32x2 a1, f32x2 a2, f32x2 a3, const f32x2 w1, f32x2& o0, f32x2& o1, f32x2& o2, f32x2& o3) {
    const f32x2 w2 = cmul(w1, w1), w3 = cmul(w2, w1);
    a1 = cmul(a1, w1); a2 = cmul(a2, w2); a3 = cmul(a3, w3);
    const f32x2 v0 = a0 + a2, v1 = a0 - a2, v2 = a1 + a3, t3 = a1 - a3; const f32x2 v3 = {t3.y, -t3.x};
    o0 = v0 + v2; o1 = v1 + v3; o2 = v0 - v2; o3 = v1 - v3;
}
template <int LOGN, bool ZP = false> __device__ __forceinline__ void fft_lds(LAS f32x2* buf, int tid) {
    constexpr int N = 1 << LOGN, T16 = N >> 4, T2 = N >> 1;
    const LAS f32x2* tw = (const LAS f32x2*)((LAS unsigned char*)buf + TW_OFF);
    int p = 1, toff = 0, ps0 = 0;
    if (ZP) {
        const int b = tid >> (LOGN - 4), i = tid & (T16 - 1), base = b << LOGN;
        f32x2 u[8];
#pragma unroll
        for (int q = 0; q < 8; ++q) u[q] = buf[FPAD(base + i + q * T16)];
        f32x2 v[4][4], o[4][4];
#pragma unroll
        for (int m = 0; m < 4; ++m) { const f32x2 a0 = u[m], a1 = u[m + 4];
            v[m][0] = a0 + a1; v[m][1] = (f32x2){a0.x + a1.y, a0.y - a1.x}; v[m][2] = a0 - a1; v[m][3] = (f32x2){a0.x - a1.y, a0.y + a1.x}; }
#pragma unroll
        for (int r = 0; r < 4; ++r) r4bf(v[0][r], v[1][r], v[2][r], v[3][r], tw[1 + r], o[r][0], o[r][1], o[r][2], o[r][3]);
        __syncthreads();
        const int jb = base + 16 * i;
#pragma unroll
        for (int r = 0; r < 4; ++r)
#pragma unroll
            for (int r2 = 0; r2 < 4; ++r2) buf[FPAD(jb + r + 4 * r2)] = o[r][r2];
        __syncthreads();
        toff = 5; p = 16; ps0 = 1;
    }
#pragma unroll 1
    for (int ps = ps0; ps < (LOGN - 1) / 4; ++ps) {
        const int b = tid >> (LOGN - 4), i = tid & (T16 - 1), base = b << LOGN, k = i & (p - 1);
        f32x2 u[16];
#pragma unroll
        for (int q = 0; q < 16; ++q) u[q] = buf[FPAD(base + i + q * T16)];
        f32x2 v[4][4], o[4][4];
        { const f32x2 w1 = tw[toff + k];
#pragma unroll
          for (int m = 0; m < 4; ++m) r4bf(u[m], u[m + 4], u[m + 8], u[m + 12], w1, v[m][0], v[m][1], v[m][2], v[m][3]); }
#pragma unroll
        for (int r = 0; r < 4; ++r) { const f32x2 w1 = tw[toff + p + k + r * p];
            r4bf(v[0][r], v[1][r], v[2][r], v[3][r], w1, o[r][0], o[r][1], o[r][2], o[r][3]); }
        __syncthreads();
        const int jb = base + 16 * (i - k) + k;
#pragma unroll
        for (int r = 0; r < 4; ++r)
#pragma unroll
            for (int r2 = 0; r2 < 4; ++r2) buf[FPAD(jb + r * p + 4 * p * r2)] = o[r][r2];
        __syncthreads();
        toff += 5 * p; p <<= 4;
    }
#pragma unroll
    for (int q = 0; q < 8; ++q) {
        const int g = tid + q * 512, b = g >> (LOGN - 1), i = g & (T2 - 1), base = b << LOGN;
        const f32x2 u0 = buf[FPAD(base + i)]; f32x2 u1 = buf[FPAD(base + i + T2)];
        u1 = cmul(u1, tw[(LOGN == 13 ? TW_R13 : TW_R9) + i]);
        buf[FPAD(base + i)] = u0 + u1; buf[FPAD(base + i + T2)] = u0 - u1;
    }
    __syncthreads();
}

template <int LOGN> __device__ __forceinline__ void filter_unit(const Args& a, LAS unsigned char* lds, int unit) {
    constexpr int N = 1 << LOGN, n = N >> 1, NB = 8192 >> LOGN;
    const int tid = otid();
    LAS f32x2* buf = (LAS f32x2*)lds; LAS f32x2* red = (LAS f32x2*)(lds + 131072); LAS f32x2* sums = red + 512;
    const int c0 = unit * 2 * NB;
    const float* HFB = (const float*)(a.ws + WS_HFB) + (n == 256 ? 0 : 256);
    const float zz = ozero();
#pragma unroll
    for (int q = 0; q < 8; ++q) {
        const int item = tid + q * 512, t = item & (n - 1), cb = item >> (LOGN - 1), ca = c0 + 2 * cb;
        const float hfa = HFB[(size_t)ca * 4352 + t], hba = HFB[(size_t)(1024 + ca) * 4352 + t];
        const float hfb = HFB[(size_t)(ca + 1) * 4352 + t], hbb = HFB[(size_t)(1024 + ca + 1) * 4352 + t];
        buf[FPAD(cb * N + t)] = (f32x2){hfa, hfb};
        if (t >= 1) buf[FPAD(cb * N + N - t)] = (f32x2){hba, hbb}; else buf[FPAD(cb * N + n)] = (f32x2){zz, zz};
    }
    __syncthreads();
    { f32x2 s = {zz, zz};
#pragma unroll
      for (int i = 0; i < 16; ++i) { const f32x2 v = buf[tid * 17 + i]; s.x += fabsf(v.x); s.y += fabsf(v.y); }
      red[tid] = s; }
    __syncthreads();
    if (tid < 64) {
        f32x2 s = {zz, zz};
#pragma unroll
        for (int i = 0; i < 8; ++i) s = s + red[tid * 8 + i];
#pragma unroll
        for (int o = 1; o < 64 / NB; o <<= 1) { s.x += __shfl_xor(s.x, o); s.y += __shfl_xor(s.y, o); }
        if ((tid & (64 / NB - 1)) == 0) sums[tid / (64 / NB)] = (f32x2){0.5f / s.x, 0.5f / s.y};
    }
    __syncthreads();
    fft_lds<LOGN>(buf, tid);
    f32x2* SP = (f32x2*)(a.ws + WS_Z + (n == 256 ? SPEC_P_OFF : 0)); const int stride = n == 256 ? SPP_STRIDE : SPS_STRIDE;
    for (int idx = tid; idx < NB * (n + 1); idx += 512) { const int cb = idx / (n + 1), k = idx - cb * (n + 1);
        const f32x2 zk = buf[FPAD(cb * N + k)], zm = buf[FPAD(cb * N + ((N - k) & (N - 1)))]; const f32x2 sc = sums[cb];
        SP[(size_t)(c0 + 2 * cb) * stride + k] = (f32x2){(zk.x + zm.x) * sc.x, (zk.y - zm.y) * sc.x};
        SP[(size_t)(c0 + 2 * cb + 1) * stride + k] = (f32x2){(zk.y + zm.y) * sc.y, (zm.x - zk.x) * sc.y}; }
    __syncthreads();
}

__device__ __forceinline__ void hfb_unit(const Args& a, LAS unsigned char* lds, int unit) {
    const int tid = otid(), w = tid >> 6, l = tid & 63;
    LAS float* As = (LAS float*)lds; LAS float* Ws = (LAS float*)(lds + 20480);
    const int tt = unit >> 4, ct = unit & 15, p0 = tt * 64, cc0 = ct * 128;
    const float* A3 = (const float*)(a.ws + WS_A3); const float* w3 = a.in[34];
    { const int t = tid >> 3, k0 = (tid & 7) * 8; const f32x4 v0 = *(const f32x4*)(A3 + (size_t)(p0 + t) * 64 + k0), v1 = *(const f32x4*)(A3 + (size_t)(p0 + t) * 64 + k0 + 4);
      LAS float* d = As + t * 65 + k0; d[0] = v0.x; d[1] = v0.y; d[2] = v0.z; d[3] = v0.w; d[4] = v1.x; d[5] = v1.y; d[6] = v1.z; d[7] = v1.w; }
#pragma unroll
    for (int q = 0; q < 4; ++q) { const int idx = tid + q * 512, k = idx >> 5, c4 = idx & 31; *(LAS f32x4*)(Ws + k * 128 + c4 * 4) = *(const f32x4*)(w3 + (size_t)k * 2048 + cc0 + c4 * 4); }
    __syncthreads();
    f32x4 acc[4];
#pragma unroll
    for (int q = 0; q < 4; ++q) acc[q] = (f32x4){0.f, 0.f, 0.f, 0.f};
#pragma unroll 8
    for (int k = 0; k < 64; ++k) { const float av = As[l * 65 + k];
#pragma unroll
        for (int q = 0; q < 4; ++q) acc[q] = acc[q] + *(const LAS f32x4*)(Ws + k * 128 + w * 16 + 4 * q) * av; }
    const int pos = p0 + l, n = pos < 256 ? 256 : 4096, t = pos < 256 ? pos : pos - 256;
    const float t01 = (float)t / (float)(n - 1);
    const float dlo = -3.0701134573253946f, dhi = -15.350567286626973f;
    float* HFB = (float*)(a.ws + WS_HFB);
#pragma unroll
    for (int q = 0; q < 4; ++q)
#pragma unroll
        for (int e = 0; e < 4; ++e) { const int cc = cc0 + w * 16 + 4 * q + e; const float delta = fabsf(dlo + (dhi - dlo) * (float)(cc & 1023) / 1023.0f);
            HFB[(size_t)cc * 4352 + pos] = acc[q][e] * expf(-t01 * delta); }
    __syncthreads();
}

template <int LOGN> __device__ __forceinline__ void conv_unit(const Args& a, LAS unsigned char* lds, int c, int pr) {
    constexpr int N = 1 << LOGN, n = N >> 1, NB = 8192 >> LOGN, CPS = n / 8;
    const int tid = otid();
    LAS f32x2* buf = (LAS f32x2*)lds; LAS float* bufF = (LAS float*)lds;
    const float zz = ozero();
    bf16_t* VXT = (bf16_t*)(a.ws + WS_XS) + (n == 256 ? 0 : (size_t)32 * 1024 * 256);
#pragma unroll
    for (int q = 0; q < 2; ++q) {
        const int chunk = tid + q * 512, sq = chunk / CPS, ck = chunk - sq * CPS, pair = sq >> 1, part = sq & 1;
        const int bsel = (n == 256) ? (2 * pair + part) : (2 * pr + part);
        float f[8]; unpack8(*(const u32x4*)(VXT + ((size_t)bsel * 1024 + c) * n + ck * 8), f);
#pragma unroll
        for (int i = 0; i < 8; ++i) bufF[FPAD(pair * N + ck * 8 + i) * 2 + part] = f[i];
    }
    __syncthreads();
    fft_lds<LOGN, true>(buf, tid);
    const f32x2* SP = (const f32x2*)(a.ws + WS_Z + (n == 256 ? SPEC_P_OFF : 0)) + (size_t)c * (n == 256 ? SPP_STRIDE : SPS_STRIDE);
    { f32x2 F[16];
#pragma unroll
      for (int q = 0; q < 16; ++q) { const int k = (tid + q * 512) & (N - 1); F[q] = SP[k <= n ? k : N - k]; }
#pragma unroll
      for (int q = 0; q < 16; ++q) { const int idx = tid + q * 512, k = idx & (N - 1);
          f32x2 Fq = F[q]; if (k > n) Fq.y = -Fq.y;
          const f32x2 w = cmul(buf[FPAD(idx)], Fq); buf[FPAD(idx)] = (f32x2){w.x, -w.y}; } }
    __syncthreads();
    fft_lds<LOGN>(buf, tid);
    const float sc = 1.0f / (float)N;
#pragma unroll
    for (int q = 0; q < 2; ++q) {
        const int chunk = tid + q * 512, sq = chunk / CPS, ck = chunk - sq * CPS, pair = sq >> 1, part = sq & 1;
        const int bsel = (n == 256) ? (2 * pair + part) : (2 * pr + part);
        float f[8];
#pragma unroll
        for (int i = 0; i < 8; ++i) { const float v = bufF[FPAD(pair * N + ck * 8 + i) * 2 + part]; f[i] = part ? -v * sc : v * sc; }
        *(u32x4*)(VXT + ((size_t)bsel * 1024 + c) * n + ck * 8) = pack8(f);
    }
    __syncthreads();
}

__device__ __forceinline__ void hy_load6(const bf16_t* U3, int row0, int col, int t0, int L, u32x4 (&raw)[6]) {
#pragma unroll
    for (int r = 0; r < 6; ++r) { const int t = t0 + r - 1; raw[r] = (t >= 0 && t < L) ? *(const u32x4*)(U3 + (size_t)(row0 + r - 1) * 3072 + col) : (u32x4){0u, 0u, 0u, 0u}; }
}
__device__ __forceinline__ void hy_conv4x8(const u32x4 (&raw)[6], int col, const float* cw, const float* cb, float (&o)[4][8]) {
    float w0[8], w1[8], w2[8], bb[8];
    { const f32x4 a0 = *(const f32x4*)(cw + col), a1 = *(const f32x4*)(cw + col + 4), b0 = *(const f32x4*)(cw + 3072 + col), b1 = *(const f32x4*)(cw + 3072 + col + 4),
                  d0 = *(const f32x4*)(cw + 6144 + col), d1 = *(const f32x4*)(cw + 6144 + col + 4), e0 = *(const f32x4*)(cb + col), e1 = *(const f32x4*)(cb + col + 4);
#pragma unroll
      for (int i = 0; i < 4; ++i) { w0[i] = a0[i]; w0[4 + i] = a1[i]; w1[i] = b0[i]; w1[4 + i] = b1[i]; w2[i] = d0[i]; w2[4 + i] = d1[i]; bb[i] = e0[i]; bb[4 + i] = e1[i]; } }
    float win[6][8];
#pragma unroll
    for (int r = 0; r < 6; ++r) unpack8(raw[r], win[r]);
#pragma unroll
    for (int r = 0; r < 4; ++r)
#pragma unroll
        for (int i = 0; i < 8; ++i) o[r][i] = w0[i] * win[r][i] + w1[i] * win[r + 1][i] + w2[i] * win[r + 2][i] + bb[i];
}
#define HT_SW(c, q) ((c) * HT_P + ((((q) + ((c) >> 3)) & 31) << 2))
constexpr int HT_P = 132;
template <int MODE> __device__ __forceinline__ void hy_tile_phase(const Args& a, LAS unsigned char* lds) {
    const int tid = otid(), G = ogrid();
    const bf16_t* U3 = (const bf16_t*)(a.ws + WS_AR); bf16_t* VX = (bf16_t*)(a.ws + WS_XS); bf16_t* Z = (bf16_t*)(a.ws + WS_Z);
    const float* cw = a.in[26]; const float* cb = a.in[27]; const float* hb = a.in[36];
    LAS float* T = (LAS float*)lds;
    const int cgp = tid & 15, strip = tid >> 4;
    for (int u = obid(); u < (M / 128) * 8; u += G) {
        const int rt = u >> 3, ct = u & 7, row0 = rt * 128, c0 = ct * 128;
        const bool pr = row0 < MP; const int L = pr ? 256 : 4096, b = pr ? (row0 >> 8) : ((row0 - MP) >> 12), t0 = pr ? (row0 & 255) : ((row0 - MP) & 4095);
        bf16_t* seq = VX + (pr ? 0 : (size_t)32 * 1024 * 256) + ((size_t)b * 1024 + c0) * L + t0;
        const int c = c0 + cgp * 8, r0 = strip * 4, row = row0 + r0, t = t0 + r0;
        u32x4 raw1[6], raw2[6];
        hy_load6(U3, row, 1024 + c, t, L, raw1); hy_load6(U3, row, 2048 + c, t, L, raw2);
        if (MODE == 1) {
            u32x4 yr[4];
#pragma unroll
            for (int q = 0; q < 4; ++q) { const int it = tid + q * 512, c = it >> 4, ck = it & 15; yr[q] = *(const u32x4*)(seq + (size_t)c * L + ck * 8); }
#pragma unroll
            for (int q = 0; q < 4; ++q) { const int it = tid + q * 512, c = it >> 4, ck = it & 15; float f[8]; unpack8(yr[q], f);
                *(LAS f32x4*)(T + HT_SW(c, 2 * ck)) = (f32x4){f[0], f[1], f[2], f[3]}; *(LAS f32x4*)(T + HT_SW(c, 2 * ck + 1)) = (f32x4){f[4], f[5], f[6], f[7]}; }
            __syncthreads();
        }
        {
            float x1[4][8], v[4][8];
            hy_conv4x8(raw1, 1024 + c, cw, cb, x1); hy_conv4x8(raw2, 2048 + c, cw, cb, v);
            if (MODE == 0) {
#pragma unroll
                for (int i = 0; i < 8; ++i) *(LAS f32x4*)(T + HT_SW(cgp * 8 + i, strip)) = (f32x4){v[0][i] * x1[0][i], v[1][i] * x1[1][i], v[2][i] * x1[2][i], v[3][i] * x1[3][i]};
            } else {
                u32x4 raw0[6]; hy_load6(U3, row, c, t, L, raw0);
                float x0[4][8], hbv[8]; hy_conv4x8(raw0, c, cw, cb, x0);
                { const f32x4 h0 = *(const f32x4*)(hb + c), h1 = *(const f32x4*)(hb + c + 4);
#pragma unroll
                  for (int i = 0; i < 4; ++i) { hbv[i] = h0[i]; hbv[4 + i] = h1[i]; } }
                f32x4 yv[8];
#pragma unroll
                for (int i = 0; i < 8; ++i) yv[i] = *(const LAS f32x4*)(T + HT_SW(cgp * 8 + i, strip));
#pragma unroll
                for (int r = 0; r < 4; ++r) { float o[8];
#pragma unroll
                    for (int i = 0; i < 8; ++i) o[i] = (yv[i][r] + v[r][i] * x1[r][i] * hbv[i]) * x0[r][i];
                    *(u32x4*)(Z + (size_t)(row + r) * 1024 + c) = pack8(o); }
            }
        }
        __syncthreads();
        if (MODE == 0) {
#pragma unroll
            for (int q = 0; q < 4; ++q) { const int it = tid + q * 512, c = it >> 4, ck = it & 15;
                const f32x4 a0 = *(const LAS f32x4*)(T + HT_SW(c, 2 * ck)), a1 = *(const LAS f32x4*)(T + HT_SW(c, 2 * ck + 1));
                float f[8] = {a0.x, a0.y, a0.z, a0.w, a1.x, a1.y, a1.z, a1.w};
                *(u32x4*)(seq + (size_t)c * L + ck * 8) = pack8(f); }
            __syncthreads();
        }
    }
}

#define XB_XCNT(j)  (256  + 64 * (j))
#define XB_XSUB(j)  (1280 + 64 * (j))
#define XB_XGEN(j)  (2304 + 64 * (j))
#define XB_TOP      3328
#define XB_TOPGEN   3392
#define XB_WORDS    3456
__device__ __forceinline__ unsigned xb_ld(unsigned* p) { return __hip_atomic_load(p, __ATOMIC_RELAXED, __HIP_MEMORY_SCOPE_AGENT); }
__device__ __forceinline__ unsigned xb_add(unsigned* p, unsigned v) { return __hip_atomic_fetch_add(p, v, __ATOMIC_RELAXED, __HIP_MEMORY_SCOPE_AGENT); }
__device__ __forceinline__ unsigned xb_xcc_id() { return (unsigned)__builtin_amdgcn_s_getreg((3 << 11) | 20) & 0xFu; }
#define XB_SPIN(cond) do { unsigned _sp = 0; while (cond) { __builtin_amdgcn_s_sleep(1); if (++_sp > (1u << 24)) break; } } while (0)
__device__ __forceinline__ void gbar(unsigned* bar, unsigned x, volatile LAS unsigned* cw) {
    asm volatile("s_waitcnt vmcnt(0) lgkmcnt(0)" ::: "memory");
    __syncthreads();
    if (threadIdx.x == 0) {
        const unsigned nloc = cw[0], nx = cw[1];
        const unsigned old = xb_add(&bar[XB_XSUB(x)], 1u);
        const unsigned gen = old / nloc;
        if (old + 1u == (gen + 1u) * nloc) {
            __builtin_amdgcn_fence(__ATOMIC_RELEASE, "agent");
            asm volatile("s_waitcnt vmcnt(0)" ::: "memory");
            const unsigned og = xb_add(&bar[XB_TOP], 1u);
            const unsigned tg = og / nx;
            if (og + 1u == (tg + 1u) * nx) xb_add(&bar[XB_TOPGEN], 1u);
            else XB_SPIN(xb_ld(&bar[XB_TOPGEN]) == tg);
            __builtin_amdgcn_fence(__ATOMIC_ACQUIRE, "agent");
            xb_add(&bar[XB_XGEN(x)], 1u);
            asm volatile("s_waitcnt vmcnt(0)" ::: "memory");
        } else {
            XB_SPIN(xb_ld(&bar[XB_XGEN(x)]) == gen);
            __builtin_amdgcn_fence(__ATOMIC_ACQUIRE, "agent");
            asm volatile("s_waitcnt vmcnt(0)" ::: "memory");
        }
    }
    __syncthreads();
}

struct GP { const bf16_t* A; const bf16_t* Bt; int M_, N_, K_; int kind;
            void* O; int ldc; const float* bias; int nb; int act, f32out, norm, remap;
            const float* g; const float* gsn; };

__global__ void __launch_bounds__(512, 2) fwd(Args a) {
    extern __shared__ __attribute__((aligned(16))) unsigned char lds_raw[];
    LAS unsigned char* lds = (LAS unsigned char*)lds_raw;
    cg::grid_group grid = cg::this_grid();
    unsigned char* ws = a.ws;
    unsigned* bar = (unsigned*)(ws + WS_BAR);
    const unsigned myx = xb_xcc_id();
    volatile LAS unsigned* cw = (volatile LAS unsigned*)(lds + LDS_BYTES - 32);
    if (threadIdx.x == 0) *(volatile LAS unsigned*)(lds + LDS_BYTES - 16) = xb_add(&bar[XB_XCNT(myx)], 1u);
    __syncthreads();
    const unsigned myrank = (unsigned)__builtin_amdgcn_readfirstlane((int)*(volatile LAS unsigned*)(lds + LDS_BYTES - 16));
    int vbid = (int)blockIdx.x;
    const float* MODV = (const float*)(ws + WS_MODV); const float* GS = (const float*)(ws + WS_GS); const float* BIAS = (const float*)(ws + WS_BIAS);
    float* SSQ = (float*)(ws + WS_SSQ);
    bf16_t* XS = (bf16_t*)(ws + WS_XS); bf16_t* Zb = (bf16_t*)(ws + WS_Z); bf16_t* AR = (bf16_t*)(ws + WS_AR);
    const bf16_t* W1 = (const bf16_t*)(ws + WS_MLP1); const bf16_t* W2 = (const bf16_t*)(ws + WS_MLP2);
#define WPTR(off) ((const bf16_t*)(ws + WS_W + (off)))
    for (int ph = a.ph_lo; ph < a.ph_hi; ++ph) {
      if (ph == 10) continue;
      const int G = ogrid();
      const int ndup = 1 + (int)((DUP_MASK >> ph) & 1u);
      for (int dup = 0; dup < ndup; ++dup) {
        int nrep = 0;
        GP p; p.A = nullptr; p.Bt = nullptr; p.M_ = M; p.N_ = 0; p.K_ = 1024; p.kind = 0; p.O = nullptr; p.ldc = 0; p.bias = nullptr; p.nb = 0; p.act = 0; p.f32out = 0; p.norm = 0; p.remap = 0; p.g = nullptr; p.gsn = nullptr;
        switch (ph) {
            case 0: phase0(a, lds); break;
            case 1: phase1(a, lds); break;
            case 3: sc_conv_phase(a, 0); break;
            case 23: sc_conv_phase(a, 1); break;
            case 8: mla_latent_phase(a); break;
            case 10: kq_finalize_phase(a, lds); break;
            case 11: attn_phase(a, lds, vbid); break;
            case 16: {
                hy_tile_phase<0>(a, lds);
            } break;
            case 17: {
                const int bx = obid();
                build_twiddles(lds, otid());
                for (int u = bx; u < 3072; u += G) { if (u < 2048) conv_unit<13>(a, lds, u >> 1, u & 1); else conv_unit<9>(a, lds, u - 2048, 0); }
            } break;
            case 18: hy_tile_phase<1>(a, lds); break;
            case 2: case 22: nrep = 1; p.kind = 1; p.A = XS; p.Bt = WPTR(ph == 2 ? OFF_SCIN0 : OFF_SCIN1); p.N_ = 3072; p.O = AR; p.ldc = 3072; p.bias = BIAS + (ph == 2 ? B_IN0 : B_IN3); p.nb = 3072; p.norm = 1; break;
            case 15: nrep = 1; p.kind = 1; p.A = XS; p.Bt = WPTR(OFF_HYIN); p.N_ = 3072; p.O = AR; p.ldc = 3072; p.bias = BIAS + B_HY; p.nb = 3072; p.norm = 1; break;
            case 5: case 13: case 20: case 25: { const int l = ph == 5 ? 0 : ph == 13 ? 1 : ph == 20 ? 2 : 3;
                nrep = 1; p.kind = 1; p.A = XS; p.Bt = W1; p.N_ = 4096; p.O = AR; p.ldc = 4096; p.bias = BIAS + (l == 0 ? B_M0 : l == 1 ? B_M1 : l == 2 ? B_M2 : B_M3); p.nb = 4096; p.norm = 1; p.act = 1; } break;
            case 7: nrep = 1; p.kind = 1; p.A = XS; p.Bt = WPTR(OFF_DQKV); p.N_ = 768; p.O = (void*)(ws + WS_AR + AR_QKVL); p.ldc = 768; p.bias = BIAS + B_DQKV; p.nb = 768; p.norm = 1; p.f32out = 1; break;
            case 9: nrep = 2; break;
            case 4: case 24: { const int l = ph == 4 ? 0 : 3; nrep = 1; p.kind = 2; p.A = Zb; p.Bt = WPTR(ph == 4 ? OFF_SCOUT0 : OFF_SCOUT1); p.N_ = 1024; p.g = MODV + (size_t)l * 5 * 6144 + 2 * 1024; p.gsn = GS + (size_t)(l * 2 + 1) * 5120; } break;
            case 12: nrep = 1; p.kind = 2; p.A = (const bf16_t*)(ws + WS_AR + AR_AO); p.Bt = WPTR(OFF_WO); p.N_ = 1024; p.g = MODV + (size_t)1 * 5 * 6144 + 2 * 1024; p.gsn = GS + (size_t)(1 * 2 + 1) * 5120; break;
            case 19: nrep = 1; p.kind = 2; p.A = Zb; p.Bt = WPTR(OFF_HYOUT); p.N_ = 1024; p.g = MODV + (size_t)2 * 5 * 6144 + 2 * 1024; p.gsn = GS + (size_t)(2 * 2 + 1) * 5120; break;
            case 6: case 14: case 21: case 26: { const int l = ph == 6 ? 0 : ph == 14 ? 1 : ph == 21 ? 2 : 3;
                nrep = 1; p.kind = 2; p.A = AR; p.Bt = W2; p.N_ = 1024; p.K_ = 4096; p.g = MODV + (size_t)l * 5 * 6144 + 5 * 1024; p.gsn = l < 3 ? GS + (size_t)((l + 1) * 2) * 5120 : nullptr; } break;
            default: break;
        }
        for (int rep = 0; rep < nrep; ++rep) {
            if (ph == 9) {
                p.kind = 1; p.norm = 0; p.bias = nullptr; p.act = 0; p.f32out = 0;
                if (rep == 0) { p.A = (const bf16_t*)(ws + WS_AR + AR_CQ); p.Bt = WPTR(OFF_WUQ); p.M_ = M; p.N_ = 1536; p.K_ = 384; p.O = (void*)XS; p.ldc = 1536; p.remap = 0; }
                else { p.A = (const bf16_t*)(ws + WS_AR + AR_CKV); p.Bt = WPTR(OFF_WUKV); p.M_ = MKV; p.N_ = 2048; p.K_ = 256; p.O = (void*)(ws + WS_AR + AR_KV); p.ldc = 2560; p.remap = 1; }
            }
            pg8::Gemm g{p.A, p.Bt, p.M_, p.N_, p.K_}; pg8::StaticOrder S; S.init(p.M_, p.N_, G, vbid);
            if (p.kind == 1) { pg8::EpiA E{p.O, p.ldc, p.bias, p.nb, SSQ, p.act, p.f32out, p.norm, p.remap}; pg8::gemm_phase<pg8::EpiA>(lds, g, S, E);
                               if (ph == 9 && rep == 1) k_finalize_own_units(a, lds, S);
                               if (ph == 7 && vbid >= 32) do_transposes(a, lds, 11, 13, 1, vbid - 32, G - 32);
                               if (ph == 22 && vbid >= G / 2) do_transposes(a, lds, 11, 13, 3, vbid - G / 2, G - G / 2); }
            else { pg8::EpiB E{a.out, p.g, p.gsn, XS, SSQ, ph == 4 ? a.in[0] : nullptr, ph == 4 ? a.in[1] : nullptr}; pg8::gemm_phase<pg8::EpiB>(lds, g, S, E);
                   if (ph == 19 && vbid >= G / 2) do_transposes(a, lds, 11, 13, 2, vbid - G / 2, G - G / 2);
                   if (ph == 14 && vbid >= G / 2) { build_twiddles(lds, otid());
                       for (int u = vbid - G / 2; u < 512 + 32; u += G / 2) { if (u < 512) filter_unit<13>(a, lds, u); else filter_unit<9>(a, lds, u - 512); } } }
        }
      }
        if (ph + 1 < a.ph_hi) {
            if (ph == 0) {
                grid.sync();
                unsigned mine = 0u, cnt = 0u;
#pragma unroll
                for (unsigned j = 0; j < 16; ++j) { const unsigned c = xb_ld(&bar[XB_XCNT(j)]); cnt += (c > 0u) ? 1u : 0u; mine = (j == myx) ? c : mine; }
                if (threadIdx.x == 0) { cw[0] = mine > 0u ? mine : 1u; cw[1] = cnt > 0u ? cnt : 1u; }
                { bool uni = (gridDim.x % 8u) == 0u;
#pragma unroll
                  for (unsigned j = 0; j < 16; ++j) { const unsigned c = xb_ld(&bar[XB_XCNT(j)]); uni = uni && (c == (j < 8u ? gridDim.x / 8u : 0u)); }
                  if (uni) vbid = (int)(myrank * 8u + myx); }
            } else gbar(bar, myx, cw);
            for (int e = 0; e < EXTRA_SYNCS; ++e) grid.sync();
        }
    }
#undef WPTR
}

extern "C" void kernel_launch(void* const* d_in, const int* in_sizes, int n_in, void* d_out, int out_size, void* d_ws, size_t ws_size, hipStream_t stream) {
    static int grid = 0;
    if (grid == 0) {
        if (n_in != 38 || ws_size < WS_END) { fprintf(stderr, "kernel_launch: unexpected n_in %d / ws_size %zu (need %zu)\n", n_in, ws_size, (size_t)WS_END); grid = -1; return; }
        int dev = 0, cus = 0, per_cu = 0;
        (void)hipGetDevice(&dev); (void)hipDeviceGetAttribute(&cus, hipDeviceAttributeMultiprocessorCount, dev);
        (void)hipFuncSetAttribute((const void*)fwd, hipFuncAttributeMaxDynamicSharedMemorySize, LDS_BYTES);
        if (hipOccupancyMaxActiveBlocksPerMultiprocessor(&per_cu, (const void*)fwd, 512, LDS_BYTES) != hipSuccess || per_cu < 1) per_cu = 1;
        (void)hipGetLastError();
        grid = cus * per_cu;
        if (grid <= 0) grid = 256;
    }
    if (grid < 0) return;
    (void)hipMemsetAsync((unsigned char*)d_ws + WS_BAR, 0, XB_WORDS * 4, stream);
    Args a{};
    for (int i = 0; i < 38; ++i) a.in[i] = (const float*)d_in[i];
    a.out = (float*)d_out; a.ws = (unsigned char*)d_ws;
#if ONE_LAUNCH
    a.ph_lo = 0; a.ph_hi = NPH;
    void* args[] = {&a};
    hipError_t e = hipLaunchCooperativeKernel((const void*)fwd, dim3(grid), dim3(512), args, LDS_BYTES, stream);
    if (e != hipSuccess) fprintf(stderr, "cooperative launch failed: %s (grid %d)\n", hipGetErrorString(e), grid);
#else
    for (int ph = 0; ph < NPH; ++ph) { a.ph_lo = ph; a.ph_hi = ph + 1; hipLaunchKernelGGL(fwd, dim3(grid), dim3(512), LDS_BYTES, stream, a); }
#endif
}
```
